# Optimizing an MI355X kernel written in HIP

```python
import jax
import jax.numpy as jnp
from jax import lax
import numpy as np

D_MODEL = 1024
BATCH = 4
SEQ = 8192
DEPTH = 1
DEC_BATCH = 32
DEC_SEQ = 64
PAST_LEN = 2048

CHUNK = 64
N_META = 16
D_MIX = D_MODEL
H_GDN = 4
GDN_DK = 128
GDN_DV = 128
CONV_W = 4
CONV_DIM = H_GDN * (2 * GDN_DK + GDN_DV)
H_MLA = 4
Q_LORA = 384
KV_LORA = 256
DN = 128
DR = 64
DV_MLA = 128
ROPE_BASE = 10000.0
SM_SCALE = (DN + DR) ** -0.5
QB = 128
D_FF = 2816
EPS = 1e-6
L2_EPS = 1e-6
PROJ_SIZES = (CONV_DIM, H_GDN * GDN_DV, H_GDN, H_GDN, Q_LORA, KV_LORA, DR)
N_PROJ = sum(PROJ_SIZES)

kernel_name = 'hymba_gdn_mla_macaron_stream_step'


def rmsnorm(x, g):
    xf = x.astype(jnp.float32)
    y = xf * lax.rsqrt(jnp.mean(xf * xf, axis=-1, keepdims=True) + EPS)
    return (y * g.astype(jnp.float32)).astype(x.dtype)


def l2norm(x):
    return x * lax.rsqrt(jnp.sum(x * x, axis=-1, keepdims=True) + L2_EPS)


def half_ffn(x, g, wg, wu, wd):
    h = rmsnorm(x, g)
    return x + 0.5 * ((jax.nn.silu(h @ wg) * (h @ wu)) @ wd)


def split_proj(p):
    offs = np.cumsum(PROJ_SIZES)[:-1].tolist()
    return jnp.split(p, offs, axis=-1)


def rope_tables(pos):
    inv = ROPE_BASE ** (-jnp.arange(0, DR, 2, dtype=jnp.float32) / DR)
    ang = pos.astype(jnp.float32)[:, None] * inv[None, :]
    return jnp.cos(ang), jnp.sin(ang)


def apply_rope(x, cos, sin):
    x1 = x[..., :DR // 2].astype(jnp.float32)
    x2 = x[..., DR // 2:].astype(jnp.float32)
    return jnp.concatenate([x1 * cos - x2 * sin, x2 * cos + x1 * sin], axis=-1).astype(x.dtype)


def causal_conv(xe, w):
    t = xe.shape[1] - (CONV_W - 1)
    return sum(xe[:, j:j + t] * w[j] for j in range(CONV_W))


def gdn_features(u, a, b, a_log, dt_bias):
    u = jax.nn.silu(u.astype(jnp.float32))
    q, k, v = jnp.split(u, [H_GDN * GDN_DK, 2 * H_GDN * GDN_DK], axis=-1)
    bsz, t = u.shape[:2]
    q = l2norm(q.reshape(bsz, t, H_GDN, GDN_DK)) * (GDN_DK ** -0.5)
    k = l2norm(k.reshape(bsz, t, H_GDN, GDN_DK))
    v = v.reshape(bsz, t, H_GDN, GDN_DV)
    g = -jnp.exp(a_log.astype(jnp.float32)) * jax.nn.softplus(a.astype(jnp.float32) + dt_bias.astype(jnp.float32))
    beta = jax.nn.sigmoid(b.astype(jnp.float32))
    tr = lambda z: jnp.swapaxes(z, 1, 2)
    return tr(q), tr(k), tr(v), tr(g), tr(beta)


def gdn_block(m0, q, k, v, g, beta):
    L = q.shape[2]
    causal = jnp.tril(jnp.ones((L, L), dtype=bool))
    strict = jnp.tril(jnp.ones((L, L), dtype=bool), -1)
    gc = jnp.cumsum(g, axis=-1)
    diff = gc[..., :, None] - gc[..., None, :]
    decay = jnp.where(causal, jnp.exp(jnp.where(causal, diff, 0.0)), 0.0)
    a = jnp.where(strict, beta[..., :, None] * jnp.einsum('bhtd,bhsd->bhts', k, k) * decay, 0.0)
    eg = jnp.exp(gc)[..., None]
    rhs = beta[..., None] * (v - eg * jnp.einsum('bhtd,bhde->bhte', k, m0))
    u = lax.linalg.triangular_solve(jnp.eye(L, dtype=a.dtype) + a, rhs, left_side=True, lower=True, unit_diagonal=True)
    o = eg * jnp.einsum('bhtd,bhde->bhte', q, m0) + jnp.einsum('bhts,bhse->bhte', jnp.einsum('bhtd,bhsd->bhts', q, k) * decay, u)
    g_last = gc[..., -1:]
    m = jnp.exp(g_last)[..., None] * m0 + jnp.einsum('bhsd,bhse->bhde', k * jnp.exp(g_last - gc)[..., None], u)
    return m, o


def gdn_prompt(q, k, v, g, beta):
    bsz = q.shape[0]
    m0 = jnp.zeros((bsz, H_GDN, GDN_DK, GDN_DV), jnp.float32)
    m, o_meta = gdn_block(m0, q[:, :, :N_META], k[:, :, :N_META], v[:, :, :N_META], g[:, :, :N_META], beta[:, :, :N_META])

    def to_chunks(z):
        z = z[:, :, N_META:]
        nc = z.shape[2] // CHUNK
        return jnp.moveaxis(z.reshape(z.shape[:2] + (nc, CHUNK) + z.shape[3:]), 2, 0)

    m, o_f = lax.scan(lambda mm, blk: gdn_block(mm, *blk), m, tuple(to_chunks(z) for z in (q, k, v, g, beta)))
    o_f = jnp.moveaxis(o_f, 0, 2)
    o_f = o_f.reshape(o_f.shape[:2] + (-1, GDN_DV))
    return jnp.concatenate([o_meta, o_f], axis=2), m


def gdn_output(o, z, w):
    o = jnp.swapaxes(o, 1, 2)
    bsz, t = o.shape[:2]
    n = rmsnorm(o, w)
    gate = jax.nn.silu(z.astype(jnp.float32)).reshape(bsz, t, H_GDN, GDN_DV)
    return (n * gate).reshape(bsz, t, H_GDN * GDN_DV).astype(z.dtype)


def mla_project(cq, ckv, kr, cos, sin, gq, gkv, w_uq):
    bsz, t = cq.shape[:2]
    q = (rmsnorm(cq, gq) @ w_uq).reshape(bsz, t, H_MLA, DN + DR)
    qn = q[..., :DN]
    qr = apply_rope(q[..., DN:], cos[:, None, :], sin[:, None, :])
    c = rmsnorm(ckv, gkv)
    kr = apply_rope(kr, cos, sin)
    return qn, qr, c, kr


def mla_expand(c, w_ukv):
    bsz, t = c.shape[:2]
    kv = (c @ w_ukv).reshape(bsz, t, H_MLA, DN + DV_MLA)
    return kv[..., :DN], kv[..., DN:]


def mla_attend(qn, qr, kn, kr, v, mask):
    s = (jnp.einsum('bqhd,bkhd->bhqk', qn, kn) + jnp.einsum('bqhr,bkr->bhqk', qr, kr)).astype(jnp.float32) * SM_SCALE
    if mask is not None:
        s = jnp.where(mask, s, -jnp.inf)
    p = jax.nn.softmax(s, axis=-1).astype(v.dtype)
    return jnp.einsum('bhqk,bkhd->bqhd', p, v)


def mla_prompt(qn, qr, c, kr, w_ukv, key_chunk):
    kn, v = mla_expand(c, w_ukv)
    bsz, t = c.shape[:2]
    s_len = t - N_META
    o_meta = mla_attend(qn[:, :N_META], qr[:, :N_META], kn[:, :N_META], kr[:, :N_META], v[:, :N_META], None)
    nb = s_len // QB

    def blocks(z):
        z = z[:, N_META:]
        return jnp.moveaxis(z.reshape((bsz, nb, QB) + z.shape[2:]), 1, 0)

    def one(args):
        qn_b, qr_b, j = args
        q_chunk = (j * QB + jnp.arange(QB)) // CHUNK
        mask = key_chunk[None, :] <= q_chunk[:, None]
        return mla_attend(qn_b, qr_b, kn, kr, v, mask)

    o_f = lax.map(one, (blocks(qn), blocks(qr), jnp.arange(nb)))
    o_f = jnp.moveaxis(o_f, 0, 1).reshape(bsz, s_len, H_MLA * DV_MLA)
    return jnp.concatenate([o_meta.reshape(bsz, N_META, H_MLA * DV_MLA), o_f], axis=1)


def setup_inputs(seed: int = 0) -> dict:
    key = jax.random.key(seed)
    ks = iter(jax.random.split(key, 40))
    f32 = jnp.float32
    nrm = lambda shape, scale: jax.random.normal(next(ks), shape, f32) * scale
    gain = lambda shape: 1.0 + 0.05 * jax.random.normal(next(ks), shape, f32)
    a_log = jnp.log(jax.random.uniform(next(ks), (DEPTH, H_GDN), f32, 1.0, 16.0))
    dt = jnp.exp(jax.random.uniform(next(ks), (DEPTH, H_GDN), f32, np.log(1e-3), np.log(1e-1)))
    dt_bias = dt + jnp.log(-jnp.expm1(-dt))
    return {
        'x_prompt': nrm((BATCH, SEQ, D_MODEL), 1.0),
        'x_sample': nrm((DEC_BATCH, DEC_SEQ, D_MODEL), 1.0),
        'cache_mla_ckv': nrm((DEPTH, DEC_BATCH, N_META + PAST_LEN, KV_LORA), 1.0),
        'cache_mla_krope': nrm((DEPTH, DEC_BATCH, N_META + PAST_LEN, DR), 1.0),
        'state_gdn': nrm((DEPTH, DEC_BATCH, H_GDN, GDN_DK, GDN_DV), GDN_DK ** -0.5),
        'state_conv': nrm((DEPTH, DEC_BATCH, CONV_W - 1, CONV_DIM), 1.0),
        'meta': nrm((N_META, D_MODEL), 1.0),
        'ffn1_norm': gain((DEPTH, D_MODEL)),
        'ffn1_wg': nrm((DEPTH, D_MODEL, D_FF), D_MODEL ** -0.5),
        'ffn1_wu': nrm((DEPTH, D_MODEL, D_FF), D_MODEL ** -0.5),
        'ffn1_wd': nrm((DEPTH, D_FF, D_MODEL), D_FF ** -0.5),
        'mix_norm': gain((DEPTH, D_MODEL)),
        'w_in': nrm((DEPTH, D_MODEL, N_PROJ), D_MODEL ** -0.5),
        'conv_w': nrm((DEPTH, CONV_W, CONV_DIM), CONV_W ** -0.5),
        'a_log': a_log,
        'dt_bias': dt_bias,
        'gdn_norm': gain((DEPTH, GDN_DV)),
        'q_norm': gain((DEPTH, Q_LORA)),
        'kv_norm': gain((DEPTH, KV_LORA)),
        'w_uq': nrm((DEPTH, Q_LORA, H_MLA * (DN + DR)), Q_LORA ** -0.5),
        'w_ukv': nrm((DEPTH, KV_LORA, H_MLA * (DN + DV_MLA)), KV_LORA ** -0.5),
        'w_out': nrm((DEPTH, D_MIX, D_MODEL), D_MIX ** -0.5),
        'ffn2_norm': gain((DEPTH, D_MODEL)),
        'ffn2_wg': nrm((DEPTH, D_MODEL, D_FF), D_MODEL ** -0.5),
        'ffn2_wu': nrm((DEPTH, D_MODEL, D_FF), D_MODEL ** -0.5),
        'ffn2_wd': nrm((DEPTH, D_FF, D_MODEL), D_FF ** -0.5),
        'final_norm': gain((D_MODEL,)),
    }


def reference(x_prompt, x_sample, cache_mla_ckv, cache_mla_krope, state_gdn, state_conv, meta,
              ffn1_norm, ffn1_wg, ffn1_wu, ffn1_wd, mix_norm, w_in, conv_w, a_log, dt_bias, gdn_norm,
              q_norm, kv_norm, w_uq, w_ukv, w_out, ffn2_norm, ffn2_wg, ffn2_wu, ffn2_wd, final_norm):
    bsz, s_len = x_prompt.shape[:2]
    d_seq = x_sample.shape[1]
    xp = jnp.concatenate([jnp.broadcast_to(meta[None].astype(x_prompt.dtype), (bsz, N_META, D_MODEL)), x_prompt], axis=1)
    xs = x_sample
    cos_p, sin_p = rope_tables(jnp.arange(N_META + s_len))
    cos_s, sin_s = rope_tables(cache_mla_ckv.shape[2] + jnp.arange(d_seq))
    key_chunk = jnp.concatenate([jnp.full((N_META,), -1, jnp.int32), jnp.arange(s_len, dtype=jnp.int32) // CHUNK])
    p_ckv, p_kr, p_gdn, p_conv, s_ckv, s_kr, s_gdn, s_conv = [], [], [], [], [], [], [], []
    for l in range(DEPTH):
        xp = half_ffn(xp, ffn1_norm[l], ffn1_wg[l], ffn1_wu[l], ffn1_wd[l])
        xs = half_ffn(xs, ffn1_norm[l], ffn1_wg[l], ffn1_wu[l], ffn1_wd[l])
        qkv_p, z_p, a_p, b_p, cq_p, ckv_p, kr_p = split_proj(rmsnorm(xp, mix_norm[l]) @ w_in[l])
        qkv_s, z_s, a_s, b_s, cq_s, ckv_s, kr_s = split_proj(rmsnorm(xs, mix_norm[l]) @ w_in[l])
        ext_p = jnp.pad(qkv_p, ((0, 0), (CONV_W - 1, 0), (0, 0)))
        o_p, m_p = gdn_prompt(*gdn_features(causal_conv(ext_p, conv_w[l]), a_p, b_p, a_log[l], dt_bias[l]))
        gdn_p = gdn_output(o_p, z_p, gdn_norm[l])
        ext_s = jnp.concatenate([state_conv[l].astype(qkv_s.dtype), qkv_s], axis=1)
        m_s, o_s = gdn_block(state_gdn[l].astype(jnp.float32), *gdn_features(causal_conv(ext_s, conv_w[l]), a_s, b_s, a_log[l], dt_bias[l]))
        gdn_s = gdn_output(o_s, z_s, gdn_norm[l])
        qn_p, qr_p, c_p, kro_p = mla_project(cq_p, ckv_p, kr_p, cos_p, sin_p, q_norm[l], kv_norm[l], w_uq[l])
        mla_p = mla_prompt(qn_p, qr_p, c_p, kro_p, w_ukv[l], key_chunk)
        qn_s, qr_s, c_s, kro_s = mla_project(cq_s, ckv_s, kr_s, cos_s, sin_s, q_norm[l], kv_norm[l], w_uq[l])
        c_all = jnp.concatenate([cache_mla_ckv[l].astype(c_s.dtype), c_s], axis=1)
        kr_all = jnp.concatenate([cache_mla_krope[l].astype(kro_s.dtype), kro_s], axis=1)
        kn_s, v_s = mla_expand(c_all, w_ukv[l])
        mla_s = mla_attend(qn_s, qr_s, kn_s, kr_all, v_s, None).reshape(xs.shape[0], d_seq, H_MLA * DV_MLA)
        xp = xp + jnp.concatenate([gdn_p, mla_p.astype(gdn_p.dtype)], axis=-1) @ w_out[l]
        xs = xs + jnp.concatenate([gdn_s, mla_s.astype(gdn_s.dtype)], axis=-1) @ w_out[l]
        xp = half_ffn(xp, ffn2_norm[l], ffn2_wg[l], ffn2_wu[l], ffn2_wd[l])
        xs = half_ffn(xs, ffn2_norm[l], ffn2_wg[l], ffn2_wu[l], ffn2_wd[l])
        p_ckv.append(c_p)
        p_kr.append(kro_p)
        p_gdn.append(m_p.astype(x_prompt.dtype))
        p_conv.append(qkv_p[:, -(CONV_W - 1):])
        s_ckv.append(c_s)
        s_kr.append(kro_s)
        s_gdn.append(m_s.astype(state_gdn.dtype))
        s_conv.append(ext_s[:, -(CONV_W - 1):])
    y_prompt = rmsnorm(xp[:, N_META:], final_norm)
    y_sample = rmsnorm(xs, final_norm)
    return (y_prompt, y_sample, jnp.stack(p_ckv), jnp.stack(p_kr), jnp.stack(p_gdn), jnp.stack(p_conv),
            jnp.stack(s_ckv), jnp.stack(s_kr), jnp.stack(s_gdn), jnp.stack(s_conv))
```

```cpp
#include <hip/hip_runtime.h>
#include <hip/hip_cooperative_groups.h>
#include <stdint.h>
#include <cstdio>
namespace cg = cooperative_groups;

typedef unsigned short bf16_t;
typedef short bf16x8 __attribute__((ext_vector_type(8)));
typedef short s16x4 __attribute__((ext_vector_type(4)));
typedef float f32x16 __attribute__((ext_vector_type(16)));
typedef float f32x4 __attribute__((ext_vector_type(4)));
typedef float f32x2 __attribute__((ext_vector_type(2)));
typedef unsigned u32x4 __attribute__((ext_vector_type(4)));
typedef unsigned u32x2 __attribute__((ext_vector_type(2)));
typedef __bf16 bf16x2_t __attribute__((ext_vector_type(2)));
#define DI __device__ __forceinline__
#define MFMA32(a, b, c) __builtin_amdgcn_mfma_f32_32x32x16_bf16((a), (b), (c), 0, 0, 0)

#ifndef MEGA
#define MEGA 0
#endif

constexpr int D = 1024, DFF = 2816, NPJ = 2816;
constexpr int M = 35072, ROW_S = 32768, ROW_META = 34816, ROW_PAD = 34880;
constexpr int C_Z = 1536, C_CQ = 2048, C_CKV = 2432, C_KR = 2688, C_A = 2752, C_B = 2756;
constexpr int NKEY_S = 2128;
constexpr int NTB = 2192;
constexpr float QSCALE = 0.07216878364870322f * 1.4426950408889634f;

constexpr size_t O_YS = 33554432, O_PCKV = 35651584, O_PKR = 44056576, O_PGDN = 46157824, O_PCONV = 46419968,
                 O_SCKV = 46438400, O_SKR = 46962688, O_SGDN = 47093760, O_SCONV = 49190912;
constexpr size_t al(size_t x) { return (x + 255) & ~(size_t)255; }
constexpr size_t W_XT = 0;
constexpr size_t W_CTR = al(W_XT + 256 * 1024 * 4);
constexpr size_t W_TBL = al(W_CTR + 4096);
constexpr size_t W_XN = al(W_TBL + (size_t)8208 * 64 * 4);
constexpr size_t W_HP = al(W_XN + (size_t)M * 1024 * 2);
constexpr size_t W_WGU1 = al(W_HP + (size_t)M * 2816 * 2);
constexpr size_t W_WD1 = al(W_WGU1 + (size_t)5632 * 1024 * 2);
constexpr size_t W_WIN = al(W_WD1 + (size_t)1024 * 2816 * 2);
constexpr size_t W_TB = W_WGU1;
constexpr size_t W_WO = al(W_WIN + (size_t)2816 * 1024 * 2);
constexpr size_t W_WUQ = al(W_WO + (size_t)1024 * 1024 * 2);
constexpr size_t W_WKN = al(W_WUQ + (size_t)768 * 384 * 2);
constexpr size_t W_WVT = al(W_WKN + (size_t)512 * 256 * 2);
constexpr size_t W_WUKV = al(W_WVT + (size_t)512 * 256 * 2);
constexpr size_t W_WGU2 = al(W_WUKV + (size_t)256 * 1024 * 2);
constexpr size_t W_WD2 = al(W_WGU2 + (size_t)5632 * 1024 * 2);
constexpr size_t W_Q = al(W_WD2 + (size_t)1024 * 2816 * 2);
constexpr size_t W_KN = al(W_Q + (size_t)M * 768 * 2);
constexpr size_t W_VT = al(W_KN + (size_t)M * 512 * 2);
constexpr size_t W_KC = al(W_VT + (size_t)M * 512 * 2);
constexpr size_t W_CT = al(W_KC + (size_t)32 * NKEY_S * 320 * 2);
constexpr size_t W_QS = al(W_CT + (size_t)32 * 256 * NKEY_S * 2);
constexpr size_t W_OL = al(W_QS + (size_t)2048 * 1024 * 2);
constexpr size_t W_END = al(W_OL + (size_t)2048 * 1024 * 2);
static_assert((size_t)NTB * 64 * 64 * 2 <= W_WO - W_WGU1, "Tb overlay");
static_assert(W_END <= 536870912ull, "workspace");

constexpr int LDS_BYTES = 147456;

struct Prm {
    const float *x_prompt, *x_sample, *cache_ckv, *cache_kr, *state_gdn, *state_conv, *meta, *ffn1_norm, *ffn1_wg, *ffn1_wu, *ffn1_wd,
        *mix_norm, *w_in, *conv_w, *a_log, *dt_bias, *gdn_norm, *q_norm, *kv_norm, *w_uq, *w_ukv, *w_out, *ffn2_norm, *ffn2_wg, *ffn2_wu,
        *ffn2_wd, *final_norm;
    float* out;
    unsigned char* ws;
    int phase, pad;
};

DI unsigned pk2(float lo, float hi) { f32x2 v = {lo, hi}; bf16x2_t b = __builtin_convertvector(v, bf16x2_t); return __builtin_bit_cast(unsigned, b); }
DI bf16_t f2bf(float f) { return (bf16_t)(pk2(f, 0.f) & 0xffffu); }
DI float bf2f(bf16_t h) { return __uint_as_float(((unsigned)h) << 16); }
DI float bflo(unsigned u) { return __uint_as_float(u << 16); }
DI float bfhi(unsigned u) { return __uint_as_float(u & 0xffff0000u); }
DI float wave_sum(float v) {
#pragma unroll
    for (int o = 32; o > 0; o >>= 1) v += __shfl_xor(v, o);
    return v;
}
DI float siluf(float x) { return x / (1.f + __expf(-x)); }
DI float* xrow(const Prm& p, int r) { return r < ROW_META ? p.out + (size_t)r * D : (float*)(p.ws + W_XT) + (size_t)(r - ROW_META) * D; }
DI int rowpos(int r) { return r < ROW_S ? 16 + (r & 8191) : (r < ROW_META ? 2064 + ((r - ROW_S) & 63) : ((r - ROW_META) & 15)); }
DI bf16x8 packs(const f32x16& x, int s) {
    u32x4 w;
    w.x = pk2(x[8 * s + 0], x[8 * s + 1]); w.y = pk2(x[8 * s + 2], x[8 * s + 3]);
    w.z = pk2(x[8 * s + 4], x[8 * s + 5]); w.w = pk2(x[8 * s + 6], x[8 * s + 7]);
    return __builtin_bit_cast(bf16x8, w);
}
DI bf16x8 ld_perm(const bf16_t* p) {
    s16x4 a = *(const s16x4*)p, b = *(const s16x4*)(p + 8);
    bf16x8 r; r[0] = a[0]; r[1] = a[1]; r[2] = a[2]; r[3] = a[3]; r[4] = b[0]; r[5] = b[1]; r[6] = b[2]; r[7] = b[3];
    return r;
}

template <class F> DI void cvt_w(bf16_t* dst, int K, int Nout, const float* src, int ldsrc, F colmap, int gt, int ngt) {
    const int kc = K / 8; const long items = (long)Nout * kc;
    for (long it = gt; it < items; it += ngt) {
        const int n = (int)(it % Nout), k0 = (int)(it / Nout) * 8; const int c = colmap(n);
        float v[8];
#pragma unroll
        for (int j = 0; j < 8; ++j) v[j] = c >= 0 ? src[(size_t)(k0 + j) * ldsrc + c] : 0.f;
        u32x4 w; w.x = pk2(v[0], v[1]); w.y = pk2(v[2], v[3]); w.z = pk2(v[4], v[5]); w.w = pk2(v[6], v[7]);
        *(u32x4*)(dst + (size_t)n * K + k0) = w;
    }
}
DI void norm_rows(const Prm& p, int mode, const float* gain, int gw, int ngw, int lane) {
    bf16_t* XN = (bf16_t*)(p.ws + W_XN);
    for (int r = gw; r < M; r += ngw) {
        const float* src = nullptr;
        if (mode == 0) { if (r < ROW_S) src = p.x_prompt + (size_t)r * D; else if (r < ROW_META) src = p.x_sample + (size_t)(r - ROW_S) * D; else if (r < ROW_PAD) src = p.meta + (size_t)((r - ROW_META) & 15) * D; }
        else src = xrow(p, r);
        f32x4 v[4]; float ss = 0.f;
#pragma unroll
        for (int j = 0; j < 4; ++j) { v[j] = src ? ((const f32x4*)src)[lane + 64 * j] : (f32x4){0.f, 0.f, 0.f, 0.f}; ss += v[j].x * v[j].x + v[j].y * v[j].y + v[j].z * v[j].z + v[j].w * v[j].w; }
        ss = wave_sum(ss); const float rstd = rsqrtf(ss * (1.f / D) + 1e-6f);
        if (mode == 0) { float* xo = xrow(p, r);
#pragma unroll
            for (int j = 0; j < 4; ++j) ((f32x4*)xo)[lane + 64 * j] = v[j]; }
#pragma unroll
        for (int j = 0; j < 4; ++j) { const f32x4 g = ((const f32x4*)gain)[lane + 64 * j]; u32x2 w; w.x = pk2(v[j].x * rstd * g.x, v[j].y * rstd * g.y); w.y = pk2(v[j].z * rstd * g.z, v[j].w * rstd * g.w);
            ((u32x2*)(XN + (size_t)r * D))[lane + 64 * j] = w; }
    }
}
DI void final_norm_rows(const Prm& p, int gw, int ngw, int lane) {
    for (int r = gw; r < ROW_META; r += ngw) {
        float* x = p.out + (size_t)r * D; f32x4 v[4]; float ss = 0.f;
#pragma unroll
        for (int j = 0; j < 4; ++j) { v[j] = ((const f32x4*)x)[lane + 64 * j]; ss += v[j].x * v[j].x + v[j].y * v[j].y + v[j].z * v[j].z + v[j].w * v[j].w; }
        ss = wave_sum(ss); const float rstd = rsqrtf(ss * (1.f / D) + 1e-6f);
#pragma unroll
        for (int j = 0; j < 4; ++j) { const f32x4 g = ((const f32x4*)p.final_norm)[lane + 64 * j]; ((f32x4*)x)[lane + 64 * j] = (f32x4){v[j].x * rstd * g.x, v[j].y * rstd * g.y, v[j].z * rstd * g.z, v[j].w * rstd * g.w}; }
    }
}
DI int gu_src(int n, int gran) { return n; }
DI void phase_prep(const Prm& p, int tid, int lane, int wid) {
    const int gt = blockIdx.x * 512 + tid, ngt = gridDim.x * 512, gw = blockIdx.x * 8 + wid, ngw = gridDim.x * 8;
    unsigned char* ws = p.ws;
    if (gt == 0) { ((unsigned*)(ws + W_CTR))[0] = 0u; ((unsigned*)(ws + W_CTR))[64] = 0u; }
    for (int l = 0; l < 2; ++l) {
        const float *wg = l ? p.ffn2_wg : p.ffn1_wg, *wu = l ? p.ffn2_wu : p.ffn1_wu, *wd = l ? p.ffn2_wd : p.ffn1_wd;
        bf16_t* dgu = (bf16_t*)(ws + (l ? W_WGU2 : W_WGU1)); bf16_t* dd = (bf16_t*)(ws + (l ? W_WD2 : W_WD1));
        {
            const int kc = D / 8; const long items = (long)5632 * kc;
            for (long it = gt; it < items; it += ngt) { const int n = (int)(it % 5632), k0 = (int)(it / 5632) * 8; const int blk = n >> 6, r = n & 63; const float* s = (r < 32) ? wg : wu; const int c = blk * 32 + (r & 31);
                float v[8];
#pragma unroll
                for (int j = 0; j < 8; ++j) v[j] = s[(size_t)(k0 + j) * DFF + c];
                u32x4 w; w.x = pk2(v[0], v[1]); w.y = pk2(v[2], v[3]); w.z = pk2(v[4], v[5]); w.w = pk2(v[6], v[7]);
                *(u32x4*)(dgu + (size_t)n * D + k0) = w; }
        }
        cvt_w(dd, DFF, D, wd, D, [](int n) { return n; }, gt, ngt);
    }
    cvt_w((bf16_t*)(ws + W_WIN), D, NPJ, p.w_in, 2760, [](int n) {
        if (n < 2048) return n; if (n < C_KR) return n + 8;
        if (n < C_A) { const int q = n - C_KR; return 2696 + (q >> 1) + 32 * (q & 1); }
        if (n < C_A + 4) return 2048 + (n - C_A); if (n < C_B + 4) return 2052 + (n - C_B); return -1; }, gt, ngt);
    cvt_w((bf16_t*)(ws + W_WO), D, D, p.w_out, D, [](int n) { return n; }, gt, ngt);
    cvt_w((bf16_t*)(ws + W_WUQ), 384, 768, p.w_uq, 768, [](int n) { const int h = n / 192, j = n % 192; if (j < 128) return n; const int q = j - 128; return h * 192 + 128 + (q >> 1) + 32 * (q & 1); }, gt, ngt);
    cvt_w((bf16_t*)(ws + W_WKN), 256, 512, p.w_ukv, 1024, [](int n) { return (n >> 7) * 256 + (n & 127); }, gt, ngt);
    cvt_w((bf16_t*)(ws + W_WVT), 256, 512, p.w_ukv, 1024, [](int n) { return (n >> 7) * 256 + 128 + (n & 127); }, gt, ngt);
    {
        bf16_t* d = (bf16_t*)(ws + W_WUKV);
        for (int i = gt; i < 256 * 1024 / 4; i += ngt) { const f32x4 v = ((const f32x4*)p.w_ukv)[i]; u32x2 w; w.x = pk2(v.x, v.y); w.y = pk2(v.z, v.w); ((u32x2*)d)[i] = w; }
    }
    {
        bf16_t* kc = (bf16_t*)(ws + W_KC); bf16_t* ct = (bf16_t*)(ws + W_CT);
        const long n1 = (long)32 * 2064 * 64;
        for (long it = gt; it < n1; it += ngt) { const int c4 = (int)(it & 63); const long rr = it >> 6; const int sb = (int)(rr / 2064), r = (int)(rr % 2064);
            const f32x4 v = ((const f32x4*)p.cache_ckv)[it]; u32x2 w; w.x = pk2(v.x, v.y); w.y = pk2(v.z, v.w);
            *(u32x2*)(kc + ((size_t)sb * NKEY_S + r) * 320 + 4 * c4) = w; }
        const long n2 = (long)32 * 2064 * 32;
        for (long it = gt; it < n2; it += ngt) { const int i = (int)(it & 31); const long rr = it >> 5; const int sb = (int)(rr / 2064), r = (int)(rr % 2064);
            const float a = p.cache_kr[rr * 64 + i], b = p.cache_kr[rr * 64 + 32 + i];
            *(unsigned*)(kc + ((size_t)sb * NKEY_S + r) * 320 + 256 + 2 * i) = pk2(a, b); }
        const long n3 = (long)32 * 258 * 256;
        for (long it = gt; it < n3; it += ngt) { const int l = (int)(it & 255); const long q = it >> 8; const int rc = (int)(q % 258), sb = (int)(q / 258);
            float v[8];
#pragma unroll
            for (int j = 0; j < 8; ++j) v[j] = p.cache_ckv[((size_t)sb * 2064 + rc * 8 + j) * 256 + l];
            u32x4 w; w.x = pk2(v[0], v[1]); w.y = pk2(v[2], v[3]); w.z = pk2(v[4], v[5]); w.w = pk2(v[6], v[7]);
            *(u32x4*)(ct + ((size_t)sb * 256 + l) * NKEY_S + rc * 8) = w; }
    }
    {
        float* tb = (float*)(ws + W_TBL);
        for (int it = gt; it < 8208 * 32; it += ngt) { const int pos = it >> 5, i = it & 31; const float inv = exp2f(-(float)i * (13.287712379549449f / 32.f)); float s, c; sincosf((float)pos * inv, &s, &c); tb[pos * 64 + i] = c; tb[pos * 64 + 32 + i] = s; }
    }
    norm_rows(p, 0, p.ffn1_norm, gw, ngw, lane);
}

template <class Epi> DI void gemm_simple(const bf16_t* A, int lda, const bf16_t* Bt, int ldb, int Mg, int Ng, int K, const Epi& epi, int gw, int ngw, int lane) {
    const int TN = Ng / 64, TM = Mg / 64, lr = lane & 31, hi = lane >> 5;
    for (int idx = gw; idx < TM * TN; idx += ngw) {
        const int tm = idx / TN, tn = idx % TN, m0 = tm * 64, n0 = tn * 64;
        f32x16 acc[2][2];
#pragma unroll
        for (int a = 0; a < 2; ++a)
#pragma unroll
            for (int b = 0; b < 2; ++b)
#pragma unroll
                for (int i = 0; i < 16; ++i) acc[a][b][i] = 0.f;
        const bf16_t* ap = A + (size_t)(m0 + lr) * lda + 8 * hi;
        const bf16_t* bp = Bt + (size_t)(n0 + lr) * ldb + 8 * hi;
        const size_t a32 = (size_t)32 * lda, b32 = (size_t)32 * ldb;
#pragma unroll 4
        for (int k = 0; k < K; k += 16) {
            const bf16x8 a0 = *(const bf16x8*)(ap + k), a1 = *(const bf16x8*)(ap + a32 + k);
            const bf16x8 b0 = *(const bf16x8*)(bp + k), b1 = *(const bf16x8*)(bp + b32 + k);
            acc[0][0] = MFMA32(b0, a0, acc[0][0]); acc[0][1] = MFMA32(b1, a0, acc[0][1]);
            acc[1][0] = MFMA32(b0, a1, acc[1][0]); acc[1][1] = MFMA32(b1, a1, acc[1][1]);
        }
        epi(acc, m0, n0, lr, hi);
    }
}
struct EpiGU {
    bf16_t* H;
    DI void operator()(const f32x16 (&acc)[2][2], int m0, int n0, int lr, int hi) const {
#pragma unroll
        for (int mi = 0; mi < 2; ++mi) { bf16_t* row = H + (size_t)(m0 + 32 * mi + lr) * DFF + (n0 >> 1) + 4 * hi;
#pragma unroll
            for (int g = 0; g < 4; ++g) { float v[4];
#pragma unroll
                for (int e = 0; e < 4; ++e) v[e] = siluf(acc[mi][0][4 * g + e]) * acc[mi][1][4 * g + e];
                u32x2 w; w.x = pk2(v[0], v[1]); w.y = pk2(v[2], v[3]); *(u32x2*)(row + 8 * g) = w; } }
    }
};
struct EpiRes {
    Prm p; float alpha;
    DI void operator()(const f32x16 (&acc)[2][2], int m0, int n0, int lr, int hi) const {
#pragma unroll
        for (int mi = 0; mi < 2; ++mi) { float* row = xrow(p, m0 + 32 * mi + lr) + n0 + 4 * hi;
#pragma unroll
            for (int ni = 0; ni < 2; ++ni)
#pragma unroll
                for (int g = 0; g < 4; ++g) { f32x4* q = (f32x4*)(row + 32 * ni + 8 * g); f32x4 x = *q;
                    x.x += alpha * acc[mi][ni][4 * g]; x.y += alpha * acc[mi][ni][4 * g + 1]; x.z += alpha * acc[mi][ni][4 * g + 2]; x.w += alpha * acc[mi][ni][4 * g + 3]; *q = x; } }
    }
};
struct EpiBf {
    bf16_t* O; int ldc;
    DI void operator()(const f32x16 (&acc)[2][2], int m0, int n0, int lr, int hi) const {
#pragma unroll
        for (int mi = 0; mi < 2; ++mi) { bf16_t* row = O + (size_t)(m0 + 32 * mi + lr) * ldc + n0 + 4 * hi;
#pragma unroll
            for (int ni = 0; ni < 2; ++ni)
#pragma unroll
                for (int g = 0; g < 4; ++g) { u32x2 w; w.x = pk2(acc[mi][ni][4 * g], acc[mi][ni][4 * g + 1]); w.y = pk2(acc[mi][ni][4 * g + 2], acc[mi][ni][4 * g + 3]); *(u32x2*)(row + 32 * ni + 8 * g) = w; } }
    }
};
struct EpiQ {
    bf16_t* Q; const float* tbl;
    DI void operator()(const f32x16 (&acc)[2][2], int m0, int n0, int lr, int hi) const {
        const bool rope = ((n0 >> 6) % 3) == 2;
#pragma unroll
        for (int mi = 0; mi < 2; ++mi) { const int r = m0 + 32 * mi + lr; bf16_t* row = Q + (size_t)r * 768 + n0 + 4 * hi; const float* tb = tbl + (size_t)rowpos(r) * 64;
#pragma unroll
            for (int ni = 0; ni < 2; ++ni)
#pragma unroll
                for (int g = 0; g < 4; ++g) { float v0 = acc[mi][ni][4 * g], v1 = acc[mi][ni][4 * g + 1], v2 = acc[mi][ni][4 * g + 2], v3 = acc[mi][ni][4 * g + 3];
                    if (rope) { const int i0 = (32 * ni + 8 * g + 4 * hi) >> 1; const float c0 = tb[i0], s0 = tb[32 + i0], c1 = tb[i0 + 1], s1 = tb[33 + i0];
                        const float a0 = v0 * c0 - v1 * s0, b0 = v1 * c0 + v0 * s0, a1 = v2 * c1 - v3 * s1, b1 = v3 * c1 + v2 * s1; v0 = a0; v1 = b0; v2 = a1; v3 = b1; }
                    u32x2 w; w.x = pk2(v0 * QSCALE, v1 * QSCALE); w.y = pk2(v2 * QSCALE, v3 * QSCALE); *(u32x2*)(row + 32 * ni + 8 * g) = w; } }
    }
};

DI void phase_post(const Prm& p, int gw, int ngw, int lane) {
    bf16_t* HP = (bf16_t*)(p.ws + W_HP); bf16_t* kc = (bf16_t*)(p.ws + W_KC); bf16_t* ct = (bf16_t*)(p.ws + W_CT); const float* tbl = (const float*)(p.ws + W_TBL);
    for (int r = gw; r < ROW_PAD; r += ngw) {
        bf16_t* row = HP + (size_t)r * NPJ;
        int ck_row, sidx = -1;
        float *ockv, *okr;
        if (r < ROW_S) { const int b = r >> 13, t = r & 8191; ck_row = b * 8208 + 16 + t; ockv = p.out + O_PCKV + (size_t)ck_row * 256; okr = p.out + O_PKR + (size_t)ck_row * 64; }
        else if (r < ROW_META) { sidx = r - ROW_S; ockv = p.out + O_SCKV + (size_t)sidx * 256; okr = p.out + O_SKR + (size_t)sidx * 64; }
        else { const int b = (r - ROW_META) >> 4, i = (r - ROW_META) & 15; ck_row = b * 8208 + i; ockv = p.out + O_PCKV + (size_t)ck_row * 256; okr = p.out + O_PKR + (size_t)ck_row * 64; }
        { unsigned* q = (unsigned*)(row + C_CQ); unsigned u[3]; float ss = 0.f;
#pragma unroll
          for (int j = 0; j < 3; ++j) { u[j] = q[lane + 64 * j]; const float a = bflo(u[j]), b = bfhi(u[j]); ss += a * a + b * b; }
          ss = wave_sum(ss); const float rstd = rsqrtf(ss * (1.f / 384.f) + 1e-6f);
#pragma unroll
          for (int j = 0; j < 3; ++j) { const int c = 2 * (lane + 64 * j); q[lane + 64 * j] = pk2(bflo(u[j]) * rstd * p.q_norm[c], bfhi(u[j]) * rstd * p.q_norm[c + 1]); } }
        { u32x2* q = (u32x2*)(row + C_CKV) + lane; const u32x2 u = *q; float v[4] = {bflo(u.x), bfhi(u.x), bflo(u.y), bfhi(u.y)};
          float ss = v[0] * v[0] + v[1] * v[1] + v[2] * v[2] + v[3] * v[3]; ss = wave_sum(ss); const float rstd = rsqrtf(ss * (1.f / 256.f) + 1e-6f);
          const f32x4 g = ((const f32x4*)p.kv_norm)[lane]; f32x4 c = {v[0] * rstd * g.x, v[1] * rstd * g.y, v[2] * rstd * g.z, v[3] * rstd * g.w};
          ((f32x4*)ockv)[lane] = c; u32x2 w; w.x = pk2(c.x, c.y); w.y = pk2(c.z, c.w); *q = w;
          if (sidx >= 0) { const int sb = sidx >> 6, j = sidx & 63; *(u32x2*)(kc + ((size_t)sb * NKEY_S + 2064 + j) * 320 + 4 * lane) = w;
              bf16_t* cp = ct + ((size_t)sb * 256 + 4 * lane) * NKEY_S + 2064 + j; cp[0] = (bf16_t)(w.x & 0xffff); cp[NKEY_S] = (bf16_t)(w.x >> 16); cp[2 * NKEY_S] = (bf16_t)(w.y & 0xffff); cp[3 * NKEY_S] = (bf16_t)(w.y >> 16); } }
        if (lane < 32) { unsigned* q = (unsigned*)(row + C_KR) + lane; const unsigned u = *q; const float x1 = bflo(u), x2 = bfhi(u); const float* tb = tbl + (size_t)rowpos(r) * 64; const float c = tb[lane], s = tb[32 + lane];
            const float o1 = x1 * c - x2 * s, o2 = x2 * c + x1 * s; okr[lane] = o1; okr[32 + lane] = o2; const unsigned w = pk2(o1, o2); *q = w;
            if (sidx >= 0) { const int sb = sidx >> 6, j = sidx & 63; *(unsigned*)(kc + ((size_t)sb * NKEY_S + 2064 + j) * 320 + 256 + 2 * lane) = w; } }
        if (r < ROW_S && (r & 8191) >= 8189) { float* o = p.out + O_PCONV + ((size_t)(r >> 13) * 3 + ((r & 8191) - 8189)) * 1536;
            for (int c = lane; c < 768; c += 64) { const unsigned u = ((const unsigned*)row)[c]; o[2 * c] = bflo(u); o[2 * c + 1] = bfhi(u); } }
        if (sidx >= 0 && (sidx & 63) >= 61) { float* o = p.out + O_SCONV + ((size_t)(sidx >> 6) * 3 + ((sidx & 63) - 61)) * 1536;
            for (int c = lane; c < 768; c += 64) { const unsigned u = ((const unsigned*)row)[c]; o[2 * c] = bflo(u); o[2 * c + 1] = bfhi(u); } }
    }
}

DI f32x2 gdn_raw(const Prm& p, int kind, int b, int c, int t_rel, int col) {
    const bf16_t* HP = (const bf16_t*)(p.ws + W_HP); int row;
    if (kind == 0) {
        if (c == 0) { if (t_rel < 0) return (f32x2){0.f, 0.f}; row = ROW_META + 16 * b + t_rel; }
        else { const int q = 64 * (c - 1) + t_rel; row = q >= 0 ? b * 8192 + q : ROW_META + 16 * b + 16 + q; }
    } else {
        if (t_rel < 0) { const float* s = p.state_conv + ((size_t)b * 3 + (3 + t_rel)) * 1536 + col; return (f32x2){s[0], s[1]}; }
        row = ROW_S + 64 * b + t_rel;
    }
    const unsigned u = *(const unsigned*)(HP + (size_t)row * NPJ + col); return (f32x2){bflo(u), bfhi(u)};
}
DI int gdn_row(int kind, int b, int c, int t) { return kind == 0 ? (c == 0 ? ROW_META + 16 * b + t : b * 8192 + 64 * (c - 1) + t) : ROW_S + 64 * b + t; }
DI void gdn_gates(const Prm& p, int kind, int b, int c, int h, int lane, float& gc, float& beta) {
    const bf16_t* HP = (const bf16_t*)(p.ws + W_HP); const int ntok = (kind == 0 && c == 0) ? 16 : 64;
    float g = 0.f; beta = 0.f;
    if (lane < ntok) { const bf16_t* row = HP + (size_t)gdn_row(kind, b, c, lane) * NPJ; const float a = bf2f(row[C_A + h]), bb = bf2f(row[C_B + h]);
        const float x = a + p.dt_bias[h]; const float sp = fmaxf(x, 0.f) + log1pf(__expf(-fabsf(x))); g = -__expf(p.a_log[h]) * sp; beta = 1.f / (1.f + __expf(-bb)); }
#pragma unroll
    for (int o = 1; o < 64; o <<= 1) { const float t = __shfl_up(g, o); if (lane >= o) g += t; }
    gc = g;
}
template <class F> DI void gdn_conv(const Prm& p, int kind, int b, int c, int col, int t0, int n, F f) {
    f32x2 w[4];
#pragma unroll
    for (int j = 0; j < 4; ++j) w[j] = (f32x2){p.conv_w[j * 1536 + col], p.conv_w[j * 1536 + col + 1]};
    f32x2 x0 = gdn_raw(p, kind, b, c, t0 - 3, col), x1 = gdn_raw(p, kind, b, c, t0 - 2, col), x2 = gdn_raw(p, kind, b, c, t0 - 1, col);
#pragma unroll 1
    for (int t = t0; t < t0 + n; ++t) { const f32x2 x3 = gdn_raw(p, kind, b, c, t, col);
        const float y0 = w[0].x * x0.x + w[1].x * x1.x + w[2].x * x2.x + w[3].x * x3.x, y1 = w[0].y * x0.y + w[1].y * x1.y + w[2].y * x2.y + w[3].y * x3.y;
        f(t, siluf(y0), siluf(y1)); x0 = x1; x1 = x2; x2 = x3; }
}
DI void gdn_unit_decode(int u, int& kind, int& b, int& c, int& h) { if (u < 2064) { kind = 0; b = u / 516; const int r = u % 516; c = r >> 2; h = r & 3; } else { kind = 1; b = (u - 2064) >> 2; c = 0; h = u & 3; } }

constexpr int GK_STR = 136;
DI void phase_gdn_T(const Prm& p, unsigned char* lds, int gw, int ngw, int wid, int lane) {
    bf16_t* kL = (bf16_t*)(lds + wid * 17920); float* AL = (float*)(lds + wid * 17920); float* gL = (float*)(lds + wid * 17920 + 17408);
    bf16_t* Tb = (bf16_t*)(p.ws + W_TB); const int lr = lane & 31, hi = lane >> 5;
    for (int u = gw; u < NTB; u += ngw) {
        int kind, b, c, h; gdn_unit_decode(u, kind, b, c, h);
        float gc, beta; gdn_gates(p, kind, b, c, h, lane, gc, beta); gL[lane] = gc; gL[64 + lane] = beta;
        gdn_conv(p, kind, b, c, 512 + h * 128 + 2 * lane, 0, 64, [&](int t, float y0, float y1) { const float ss = wave_sum(y0 * y0 + y1 * y1); const float rn = rsqrtf(ss + 1e-6f); *(unsigned*)(kL + t * GK_STR + 2 * lane) = pk2(y0 * rn, y1 * rn); });
        __builtin_amdgcn_s_waitcnt(0xc07f);
        f32x16 kk[3];
#pragma unroll
        for (int q = 0; q < 3; ++q)
#pragma unroll
            for (int i = 0; i < 16; ++i) kk[q][i] = 0.f;
#pragma unroll
        for (int ks = 0; ks < 8; ++ks) { const bf16x8 f0 = *(const bf16x8*)(kL + lr * GK_STR + 16 * ks + 8 * hi), f1 = *(const bf16x8*)(kL + (32 + lr) * GK_STR + 16 * ks + 8 * hi);
            kk[0] = MFMA32(f0, f0, kk[0]); kk[1] = MFMA32(f1, f0, kk[1]); kk[2] = MFMA32(f1, f1, kk[2]); }
        float gt_[2][16], bt_[2][16];
#pragma unroll
        for (int tb = 0; tb < 2; ++tb)
#pragma unroll
            for (int i = 0; i < 16; ++i) { const int t = 32 * tb + (i & 3) + 8 * (i >> 2) + 4 * hi; gt_[tb][i] = gL[t]; bt_[tb][i] = gL[64 + t]; }
        const float gs0 = gL[lr], gs1 = gL[32 + lr];
        __builtin_amdgcn_s_waitcnt(0xc07f);
        asm volatile("" ::: "memory");
#pragma unroll
        for (int i = 0; i < 16; ++i) { const int t0 = (i & 3) + 8 * (i >> 2) + 4 * hi, t1 = 32 + t0;
            AL[t0 * 64 + lr] = (lr < t0) ? bt_[0][i] * kk[0][i] * __expf(gt_[0][i] - gs0) : 0.f;
            AL[t0 * 64 + 32 + lr] = 0.f;
            AL[t1 * 64 + lr] = bt_[1][i] * kk[1][i] * __expf(gt_[1][i] - gs0);
            AL[t1 * 64 + 32 + lr] = (32 + lr < t1) ? bt_[1][i] * kk[2][i] * __expf(gt_[1][i] - gs1) : 0.f; }
        __builtin_amdgcn_s_waitcnt(0xc07f);
        asm volatile("" ::: "memory");
        float T[64];
#pragma unroll
        for (int t = 0; t < 64; ++t) { float a = (t == lane) ? 1.f : 0.f;
#pragma unroll
            for (int s4 = 0; s4 < (t + 3) / 4; ++s4) { const f32x4 av = *(const f32x4*)(AL + t * 64 + 4 * s4);
                if (4 * s4 + 0 < t) a -= av.x * T[4 * s4 + 0];
                if (4 * s4 + 1 < t) a -= av.y * T[4 * s4 + 1];
                if (4 * s4 + 2 < t) a -= av.z * T[4 * s4 + 2];
                if (4 * s4 + 3 < t) a -= av.w * T[4 * s4 + 3]; }
            T[t] = a; }
        bf16_t* out = Tb + (size_t)u * 4096;
#pragma unroll
        for (int t = 0; t < 64; ++t) out[t * 64 + lane] = f2bf(T[t] * beta);
        __builtin_amdgcn_s_waitcnt(0xc07f);
        asm volatile("" ::: "memory");
    }
}

constexpr int GS_Q = 0, GS_K = 17408, GS_KEG = 34816, GS_VT = 53248, GS_KD = 71680, GS_TB = 90112, GS_QK = 99328, GS_W = 108544, GS_G = 125952;
constexpr int GT_STR = 72;
DI void gdn_scan_unit(const Prm& p, unsigned char* lds, int kind, int b, int h, int tid, int wid, int lane) {
    bf16_t* qL = (bf16_t*)(lds + GS_Q); bf16_t* kL = (bf16_t*)(lds + GS_K); bf16_t* kegL = (bf16_t*)(lds + GS_KEG); bf16_t* vtL = (bf16_t*)(lds + GS_VT); bf16_t* kdL = (bf16_t*)(lds + GS_KD);
    bf16_t* tbL = (bf16_t*)(lds + GS_TB); bf16_t* qkL = (bf16_t*)(lds + GS_QK); bf16_t* wL = (bf16_t*)(lds + GS_W); float* gL = (float*)(lds + GS_G);
    const bf16_t* Tb = (const bf16_t*)(p.ws + W_TB); bf16_t* O = (bf16_t*)(p.ws + W_XN);
    const int lr = lane & 31, hi = lane >> 5, nch = kind == 0 ? 129 : 1;
    f32x16 Mst[4];
    const int dv = 32 * (wid & 3) + lr;
#pragma unroll
    for (int mb = 0; mb < 4; ++mb)
#pragma unroll
        for (int i = 0; i < 16; ++i) { const int dk = 32 * mb + (i & 3) + 8 * (i >> 2) + 4 * hi; Mst[mb][i] = (kind == 1 && wid < 4) ? p.state_gdn[(((size_t)b * 4 + h) * 128 + dk) * 128 + dv] : 0.f; }
    for (int c = 0; c < nch; ++c) {
        const int u = kind == 0 ? b * 516 + c * 4 + h : 2064 + b * 4 + h; const int ntok = (kind == 0 && c == 0) ? 16 : 64;
        int lrv = lr, hiv = hi, lanev = lane; asm volatile("" : "+v"(lrv), "+v"(hiv), "+v"(lanev));
        __syncthreads();
        if (wid == 0) { float gc, beta; gdn_gates(p, kind, b, c, h, lanev, gc, beta); gL[lanev] = gc; gL[64 + lanev] = beta; gL[128 + lanev] = __expf(gc); }
        __syncthreads();
        const float gl = gL[63];
        if (wid < 6) { const int part = wid % 3, th = wid / 3;
            gdn_conv(p, kind, b, c, part * 512 + h * 128 + 2 * lanev, 32 * th, 32, [&](int t, float y0, float y1) {
                if (part == 2) { vtL[(2 * lanev) * GT_STR + t] = f2bf(y0); vtL[(2 * lanev + 1) * GT_STR + t] = f2bf(y1); }
                else { const float ss = wave_sum(y0 * y0 + y1 * y1); float rn = rsqrtf(ss + 1e-6f);
                    if (part == 0) { rn *= 0.08838834764831845f; *(unsigned*)(qL + t * GK_STR + 2 * lanev) = pk2(y0 * rn, y1 * rn); }
                    else { const float k0 = y0 * rn, k1 = y1 * rn; *(unsigned*)(kL + t * GK_STR + 2 * lanev) = pk2(k0, k1); const float eg = gL[128 + t], ed = __expf(gl - gL[t]);
                        kegL[(2 * lanev) * GT_STR + t] = f2bf(k0 * eg); kegL[(2 * lanev + 1) * GT_STR + t] = f2bf(k1 * eg); kdL[(2 * lanev) * GT_STR + t] = f2bf(k0 * ed); kdL[(2 * lanev + 1) * GT_STR + t] = f2bf(k1 * ed); } } });
        } else { const int i0 = (wid - 6) * 64 + lanev;
#pragma unroll
            for (int j = 0; j < 4; ++j) { const int e = i0 + 128 * j, r = e >> 3, cc = e & 7; const u32x4 v = *(const u32x4*)(Tb + (size_t)u * 4096 + r * 64 + 8 * cc); *(u32x4*)(tbL + r * GT_STR + 8 * cc) = v; } }
        __syncthreads();
        f32x16 uu[2];
#pragma unroll
        for (int tb = 0; tb < 2; ++tb)
#pragma unroll
            for (int i = 0; i < 16; ++i) uu[tb][i] = 0.f;
        {
            const bf16_t* bsrc = (wid < 4 ? vtL : kegL) + (32 * (wid & 3) + lrv) * GT_STR + 8 * hiv;
#pragma unroll
            for (int ks = 0; ks < 4; ++ks) { const bf16x8 bf = *(const bf16x8*)(bsrc + 16 * ks);
                const bf16x8 a0 = *(const bf16x8*)(tbL + lrv * GT_STR + 16 * ks + 8 * hiv), a1 = *(const bf16x8*)(tbL + (32 + lrv) * GT_STR + 16 * ks + 8 * hiv);
                uu[0] = MFMA32(a0, bf, uu[0]); uu[1] = MFMA32(a1, bf, uu[1]); }
            if (wid >= 4) {
#pragma unroll
                for (int tb = 0; tb < 2; ++tb)
#pragma unroll
                    for (int i = 0; i < 16; ++i) { const int t = 32 * tb + (i & 3) + 8 * (i >> 2) + 4 * hiv; wL[t * GK_STR + 32 * (wid & 3) + lrv] = f2bf(-uu[tb][i]); }
                if (wid < 7) { const int q = wid - 4, tb = q ? 1 : 0, sb = q == 2 ? 1 : 0;
                    f32x16 qk;
#pragma unroll
                    for (int i = 0; i < 16; ++i) qk[i] = 0.f;
#pragma unroll
                    for (int ks = 0; ks < 8; ++ks) { const bf16x8 a = *(const bf16x8*)(qL + (32 * tb + lrv) * GK_STR + 16 * ks + 8 * hiv), bb = *(const bf16x8*)(kL + (32 * sb + lrv) * GK_STR + 16 * ks + 8 * hiv); qk = MFMA32(a, bb, qk); }
                    const int s = 32 * sb + lrv; const float gs = gL[s];
#pragma unroll
                    for (int i = 0; i < 16; ++i) { const int t = 32 * tb + (i & 3) + 8 * (i >> 2) + 4 * hiv; qkL[t * GT_STR + s] = f2bf(s <= t ? qk[i] * __expf(gL[t] - gs) : 0.f); }
                    if (q == 0) {
#pragma unroll
                        for (int i = 0; i < 16; ++i) { const int t = (i & 3) + 8 * (i >> 2) + 4 * hiv; qkL[t * GT_STR + 32 + lrv] = 0; } }
                }
            }
        }
        __syncthreads();
        if (wid < 4) {
            f32x16 oo[2];
#pragma unroll
            for (int tb = 0; tb < 2; ++tb)
#pragma unroll
                for (int i = 0; i < 16; ++i) oo[tb][i] = 0.f;
#pragma unroll
            for (int ks = 0; ks < 8; ++ks) { const bf16x8 mbf = packs(Mst[ks >> 1], ks & 1);
#pragma unroll
                for (int tb = 0; tb < 2; ++tb) { const bf16x8 wf = ld_perm(wL + (32 * tb + lrv) * GK_STR + 16 * ks + 4 * hiv), qf = ld_perm(qL + (32 * tb + lrv) * GK_STR + 16 * ks + 4 * hiv);
                    uu[tb] = MFMA32(wf, mbf, uu[tb]); oo[tb] = MFMA32(qf, mbf, oo[tb]); }
                __builtin_amdgcn_sched_barrier(0); }
#pragma unroll
            for (int tb = 0; tb < 2; ++tb)
#pragma unroll
                for (int i = 0; i < 16; ++i) oo[tb][i] *= gL[128 + 32 * tb + (i & 3) + 8 * (i >> 2) + 4 * hiv];
            bf16x8 ub[4];
#pragma unroll
            for (int ks = 0; ks < 4; ++ks) ub[ks] = packs(uu[ks >> 1], ks & 1);
#pragma unroll
            for (int tb = 0; tb < 2; ++tb)
#pragma unroll
                for (int ks = 0; ks < 4; ++ks) { const bf16x8 a = ld_perm(qkL + (32 * tb + lrv) * GT_STR + 16 * ks + 4 * hiv); oo[tb] = MFMA32(a, ub[ks], oo[tb]); }
            __builtin_amdgcn_sched_barrier(0);
            const float egl = __expf(gl);
#pragma unroll
            for (int mb = 0; mb < 4; ++mb) {
#pragma unroll
                for (int i = 0; i < 16; ++i) Mst[mb][i] *= egl;
#pragma unroll
                for (int ks = 0; ks < 4; ++ks) { const bf16x8 a = ld_perm(kdL + (32 * mb + lrv) * GT_STR + 16 * ks + 4 * hiv); Mst[mb] = MFMA32(a, ub[ks], Mst[mb]); }
                __builtin_amdgcn_sched_barrier(0);
            }
#pragma unroll
            for (int tb = 0; tb < 2; ++tb)
#pragma unroll
                for (int i = 0; i < 16; ++i) { const int t = 32 * tb + (i & 3) + 8 * (i >> 2) + 4 * hiv; if (t < ntok) O[(size_t)gdn_row(kind, b, c, t) * D + h * 128 + dv] = f2bf(oo[tb][i]); }
        }
    }
    if (wid < 4) { float* so = kind == 0 ? p.out + O_PGDN + ((size_t)b * 4 + h) * 16384 : p.out + O_SGDN + ((size_t)b * 4 + h) * 16384;
#pragma unroll
        for (int mb = 0; mb < 4; ++mb)
#pragma unroll
            for (int i = 0; i < 16; ++i) { const int dk = 32 * mb + (i & 3) + 8 * (i >> 2) + 4 * hi; so[dk * 128 + dv] = Mst[mb][i]; } }
    __syncthreads();
}

template <int DN, bool QREG> DI void attn_unit(unsigned char* lds, const bf16_t* qa_row, const bf16_t* qr_row, const bf16_t* k1, int ldk1, const bf16_t* k2, int ldk2,
                                    const bf16_t* vt, int ldvt, int r0, int r1, int ntiles, int tmax_w, bf16_t* orow, bool store, int tid, int lane) {
    constexpr int NKS = (DN + 64) / 16, KSTR = DN + 72, CPR = (DN + 64) / 8, NKC = 64 * CPR / 512, VSTR = 68;
    bf16_t* Kt = (bf16_t*)lds; bf16_t* Vt = (bf16_t*)(lds + 64 * KSTR * 2);
    const int lr = lane & 31, hi = lane >> 5;
    constexpr int NQF = QREG ? NKS : 4;
    bf16x8 qf[NQF];
#pragma unroll
    for (int ks = 0; ks < NKS; ++ks) { if (QREG) qf[ks] = (16 * ks < DN) ? *(const bf16x8*)(qa_row + 16 * ks + 8 * hi) : *(const bf16x8*)(qr_row + (16 * ks - DN) + 8 * hi);
        else if (16 * ks >= DN) qf[ks - DN / 16] = *(const bf16x8*)(qr_row + (16 * ks - DN) + 8 * hi); }
    f32x16 oacc[4];
#pragma unroll
    for (int d = 0; d < 4; ++d)
#pragma unroll
        for (int i = 0; i < 16; ++i) oacc[d][i] = 0.f;
    float mrun = -INFINITY, lrun = 0.f;
    u32x4 kreg[NKC], vreg[2];
    auto gload = [&](int t) { const int rb = t == 0 ? r0 : r1 + 64 * (t - 1);
#pragma unroll
        for (int i = 0; i < NKC; ++i) { const int e = tid + 512 * i, row = e / CPR, cc = e % CPR;
            kreg[i] = cc < DN / 8 ? *(const u32x4*)(k1 + (size_t)(rb + row) * ldk1 + 8 * cc) : *(const u32x4*)(k2 + (size_t)(rb + row) * ldk2 + 8 * (cc - DN / 8)); }
#pragma unroll
        for (int i = 0; i < 2; ++i) { const int e = tid + 512 * i, d = e >> 3, cc = e & 7; vreg[i] = *(const u32x4*)(vt + (size_t)d * ldvt + rb + 8 * cc); } };
    gload(0);
    for (int t = 0; t < ntiles; ++t) {
        __syncthreads();
#pragma unroll
        for (int i = 0; i < NKC; ++i) { const int e = tid + 512 * i, row = e / CPR, cc = e % CPR; *(u32x4*)(Kt + row * KSTR + 8 * cc) = kreg[i]; }
#pragma unroll
        for (int i = 0; i < 2; ++i) { const int e = tid + 512 * i, d = e >> 3, cc = e & 7; u32x2* q = (u32x2*)(Vt + d * VSTR + 8 * cc); q[0] = (u32x2){vreg[i].x, vreg[i].y}; q[1] = (u32x2){vreg[i].z, vreg[i].w}; }
        __syncthreads();
        if (t + 1 < ntiles) gload(t + 1);
        if (t <= tmax_w) {
            f32x16 s0, s1;
#pragma unroll
            for (int i = 0; i < 16; ++i) { s0[i] = 0.f; s1[i] = 0.f; }
#pragma unroll
            for (int ks = 0; ks < NKS; ++ks) { const bf16x8 a0 = *(const bf16x8*)(Kt + lr * KSTR + 16 * ks + 8 * hi), a1 = *(const bf16x8*)(Kt + (32 + lr) * KSTR + 16 * ks + 8 * hi);
                const bf16x8 qq = QREG ? qf[ks] : (16 * ks < DN ? *(const bf16x8*)(qa_row + 16 * ks + 8 * hi) : qf[(16 * ks - DN) / 16 < NQF ? (16 * ks - DN) / 16 : 0]);
                s0 = MFMA32(a0, qq, s0); s1 = MFMA32(a1, qq, s1);
                if ((ks & 3) == 3) __builtin_amdgcn_sched_barrier(0); }
            if (t == 0) {
#pragma unroll
                for (int i = 0; i < 16; ++i) { if (i >= 8) s0[i] = -INFINITY; s1[i] = -INFINITY; } }
            float mx = s0[0];
#pragma unroll
            for (int i = 1; i < 16; ++i) mx = fmaxf(mx, s0[i]);
#pragma unroll
            for (int i = 0; i < 16; ++i) mx = fmaxf(mx, s1[i]);
            mx = fmaxf(mx, __shfl_xor(mx, 32));
            const float mnew = fmaxf(mrun, mx), alpha = exp2f(mrun - mnew); mrun = mnew;
            float ps = 0.f;
#pragma unroll
            for (int i = 0; i < 16; ++i) { s0[i] = exp2f(s0[i] - mnew); s1[i] = exp2f(s1[i] - mnew); ps += s0[i] + s1[i]; }
            lrun = lrun * alpha + ps;
#pragma unroll
            for (int d = 0; d < 4; ++d)
#pragma unroll
                for (int i = 0; i < 16; ++i) oacc[d][i] *= alpha;
            bf16x8 pf[4]; pf[0] = packs(s0, 0); pf[1] = packs(s0, 1); pf[2] = packs(s1, 0); pf[3] = packs(s1, 1);
#pragma unroll
            for (int d = 0; d < 4; ++d)
#pragma unroll
                for (int ks = 0; ks < 4; ++ks) { const bf16x8 a = ld_perm(Vt + (32 * d + lr) * VSTR + 16 * ks + 4 * hi); oacc[d] = MFMA32(a, pf[ks], oacc[d]); if (ks == 3) __builtin_amdgcn_sched_barrier(0); }
        }
    }
    const float lt = lrun + __shfl_xor(lrun, 32), inv = 1.f / lt;
    if (store) {
#pragma unroll
        for (int d = 0; d < 4; ++d)
#pragma unroll
            for (int g = 0; g < 4; ++g) { u32x2 w; w.x = pk2(oacc[d][4 * g] * inv, oacc[d][4 * g + 1] * inv); w.y = pk2(oacc[d][4 * g + 2] * inv, oacc[d][4 * g + 3] * inv); *(u32x2*)(orow + 32 * d + 8 * g + 4 * hi) = w; }
    }
    __syncthreads();
}

#ifndef MIX_MASK
#define MIX_MASK 15
#endif
DI void phase_mix(const Prm& p, unsigned char* lds, int tid0, int wid, int lane0) {
    unsigned char* ws = p.ws; const bf16_t* Q = (const bf16_t*)(ws + W_Q); const bf16_t* KN = (const bf16_t*)(ws + W_KN); const bf16_t* VT = (const bf16_t*)(ws + W_VT);
    const bf16_t* HP = (const bf16_t*)(ws + W_HP); const bf16_t* KC = (const bf16_t*)(ws + W_KC); const bf16_t* CT = (const bf16_t*)(ws + W_CT);
    const bf16_t* QS = (const bf16_t*)(ws + W_QS); bf16_t* OL = (bf16_t*)(ws + W_OL); bf16_t* O = (bf16_t*)(ws + W_XN);
    unsigned* ctr = (unsigned*)(ws + W_CTR); unsigned* sh = (unsigned*)(lds + LDS_BYTES - 64);
    if ((MIX_MASK & 4) && blockIdx.x < 16) gdn_scan_unit(p, lds, 0, blockIdx.x >> 2, blockIdx.x & 3, tid0, wid, lane0);
    for (;;) {
        __syncthreads();
        if (tid0 == 0) sh[0] = atomicAdd(ctr, 1u);
        __syncthreads();
        const int it = (int)sh[0];
        int lane = lane0, tid = tid0; asm volatile("" : "+v"(lane), "+v"(tid)); const int lr = lane & 31;
        if (it >= 720) break;
        if ((MIX_MASK & 1) && it < 64) {
            const int sb = it >> 1, ps = it & 1, hq = wid >> 1, qrow = sb * 64 + 32 * (wid & 1) + lr;
            attn_unit<256, false>(lds, QS + (size_t)qrow * 1024 + hq * 256, Q + (size_t)(ROW_S + qrow) * 768 + hq * 192 + 128, KC + (size_t)sb * NKEY_S * 320, 320, KC + (size_t)sb * NKEY_S * 320 + 256, 320,
                           CT + ((size_t)sb * 256 + 128 * ps) * NKEY_S, NKEY_S, 0, 16, 34, 33, OL + (size_t)qrow * 1024 + hq * 256 + 128 * ps, true, tid, lane);
        } else if ((MIX_MASK & 2) && it >= 64 && it < 576) {
            const int j = it - 64, qb = 31 - (j >> 4), bh = j & 15, b = bh >> 2, h = bh & 3; const int row = b * 8192 + 256 * qb + 32 * wid + lr;
            attn_unit<128, true>(lds, Q + (size_t)row * 768 + h * 192, Q + (size_t)row * 768 + h * 192 + 128, KN + h * 128, 512, HP + C_KR, NPJ, VT + (size_t)(h * 128) * M, M,
                           ROW_META + 16 * b, b * 8192, 4 * qb + 5, 4 * qb + (wid >> 1) + 1, O + (size_t)row * D + 512 + h * 128, true, tid, lane);
        } else if ((MIX_MASK & 4) && it >= 576 && it < 704) {
            const int j = it - 576; gdn_scan_unit(p, lds, 1, j >> 2, j & 3, tid, wid, lane);
        } else if ((MIX_MASK & 8) && it >= 704) {
            const int j = it - 704, b = j >> 2, h = j & 3; const int row = ROW_META + 16 * b + lr;
            attn_unit<128, true>(lds, Q + (size_t)row * 768 + h * 192, Q + (size_t)row * 768 + h * 192 + 128, KN + h * 128, 512, HP + C_KR, NPJ, VT + (size_t)(h * 128) * M, M,
                           ROW_META + 16 * b, b * 8192, 1, wid == 0 ? 0 : -1, O + (size_t)row * D + 512 + h * 128, wid == 0 && lane < 16 || (wid == 0 && lane >= 32 && lane < 48), tid, lane);
        }
    }
}

DI void phase_gdn_gate(const Prm& p, int gw, int ngw, int lane) {
    bf16_t* O = (bf16_t*)(p.ws + W_XN); const bf16_t* HP = (const bf16_t*)(p.ws + W_HP);
    for (int r = gw; r < ROW_PAD; r += ngw) {
        u32x4* q = (u32x4*)(O + (size_t)r * D) + lane; const u32x4 u = *q; const u32x4 z = *((const u32x4*)(HP + (size_t)r * NPJ + C_Z) + lane);
        float v[8] = {bflo(u.x), bfhi(u.x), bflo(u.y), bfhi(u.y), bflo(u.z), bfhi(u.z), bflo(u.w), bfhi(u.w)};
        float zz[8] = {bflo(z.x), bfhi(z.x), bflo(z.y), bfhi(z.y), bflo(z.z), bfhi(z.z), bflo(z.w), bfhi(z.w)};
        float ss = 0.f;
#pragma unroll
        for (int j = 0; j < 8; ++j) ss += v[j] * v[j];
        ss += __shfl_xor(ss, 1); ss += __shfl_xor(ss, 2); ss += __shfl_xor(ss, 4); ss += __shfl_xor(ss, 8);
        const float rstd = rsqrtf(ss * (1.f / 128.f) + 1e-6f); const int c0 = (8 * lane) & 127;
#pragma unroll
        for (int j = 0; j < 8; ++j) v[j] = v[j] * rstd * p.gdn_norm[c0 + j] * siluf(zz[j]);
        u32x4 w; w.x = pk2(v[0], v[1]); w.y = pk2(v[2], v[3]); w.z = pk2(v[4], v[5]); w.w = pk2(v[6], v[7]); *q = w;
    }
}

constexpr int NPHASE = 17;
DI void run_phase(const Prm& p, int ph, unsigned char* lds, int tid, int wid, int lane) {
    unsigned char* ws = p.ws; const int gw = blockIdx.x * 8 + wid, ngw = gridDim.x * 8;
    bf16_t* XN = (bf16_t*)(ws + W_XN); bf16_t* HP = (bf16_t*)(ws + W_HP);
    switch (ph) {
    case 0: phase_prep(p, tid, lane, wid); break;
    case 1: gemm_simple(XN, D, (const bf16_t*)(ws + W_WGU1), D, M, 5632, D, EpiGU{HP}, gw, ngw, lane); break;
    case 2: gemm_simple(HP, DFF, (const bf16_t*)(ws + W_WD1), DFF, M, D, DFF, EpiRes{p, 0.5f}, gw, ngw, lane); break;
    case 3: norm_rows(p, 1, p.mix_norm, gw, ngw, lane); break;
    case 4: gemm_simple(XN, D, (const bf16_t*)(ws + W_WIN), D, M, NPJ, D, EpiBf{HP, NPJ}, gw, ngw, lane); break;
    case 5: phase_post(p, gw, ngw, lane); break;
    case 6:
        gemm_simple(HP + C_CQ, NPJ, (const bf16_t*)(ws + W_WUQ), 384, M, 768, 384, EpiQ{(bf16_t*)(ws + W_Q), (const float*)(ws + W_TBL)}, gw, ngw, lane);
        gemm_simple(HP + C_CKV, NPJ, (const bf16_t*)(ws + W_WKN), 256, M, 512, 256, EpiBf{(bf16_t*)(ws + W_KN), 512}, gw, ngw, lane);
        gemm_simple((const bf16_t*)(ws + W_WVT), 256, HP + C_CKV, NPJ, 512, M, 256, EpiBf{(bf16_t*)(ws + W_VT), M}, gw, ngw, lane);
        phase_gdn_T(p, lds, gw, ngw, wid, lane);
        break;
    case 7:
        for (int h = 0; h < 4; ++h)
            gemm_simple((const bf16_t*)(ws + W_Q) + (size_t)ROW_S * 768 + h * 192, 768, (const bf16_t*)(ws + W_WUKV) + h * 256, 1024, 2048, 256, 128, EpiBf{(bf16_t*)(ws + W_QS) + h * 256, 1024}, gw, ngw, lane);
        break;
    case 8: phase_mix(p, lds, tid, wid, lane); break;
    case 9:
        phase_gdn_gate(p, gw, ngw, lane);
        for (int h = 0; h < 4; ++h)
            gemm_simple((const bf16_t*)(ws + W_OL) + h * 256, 1024, (const bf16_t*)(ws + W_WVT) + (size_t)h * 128 * 256, 256, 2048, 128, 256, EpiBf{XN + (size_t)ROW_S * D + 512 + h * 128, D}, gw, ngw, lane);
        break;
    case 10: gemm_simple(XN, D, (const bf16_t*)(ws + W_WO), D, M, D, D, EpiRes{p, 1.0f}, gw, ngw, lane); break;
    case 11: norm_rows(p, 1, p.ffn2_norm, gw, ngw, lane); break;
    case 12: gemm_simple(XN, D, (const bf16_t*)(ws + W_WGU2), D, M, 5632, D, EpiGU{HP}, gw, ngw, lane); break;
    case 13: gemm_simple(HP, DFF, (const bf16_t*)(ws + W_WD2), DFF, M, D, DFF, EpiRes{p, 0.5f}, gw, ngw, lane); break;
    case 14: final_norm_rows(p, gw, ngw, lane); break;
    default: break;
    }
}

#if MEGA
__global__ void __launch_bounds__(512) k_fwd(Prm p) {
    extern __shared__ __attribute__((aligned(16))) unsigned char lds[];
    const int tid = threadIdx.x, lane = tid & 63, wid = __builtin_amdgcn_readfirstlane(tid >> 6);
    cg::grid_group grid = cg::this_grid();
#pragma unroll
    for (int ph = 0; ph < 15; ++ph) { run_phase(p, ph, lds, tid, wid, lane); if (ph < 14) grid.sync(); }
}
#else
template <int PH> __global__ void __launch_bounds__(512) k_ph(Prm p) {
    extern __shared__ __attribute__((aligned(16))) unsigned char lds[];
    const int tid = threadIdx.x, lane = tid & 63, wid = __builtin_amdgcn_readfirstlane(tid >> 6);
    run_phase(p, PH, lds, tid, wid, lane);
}
template <int PH> static void launch_ph(const Prm& p, int grid, hipStream_t stream) {
    (void)hipFuncSetAttribute((const void*)k_ph<PH>, hipFuncAttributeMaxDynamicSharedMemorySize, LDS_BYTES);
    hipLaunchKernelGGL(k_ph<PH>, dim3(grid), dim3(512), LDS_BYTES, stream, p);
}
#endif

extern "C" void kernel_launch(void* const* d_in, const int* in_sizes, int n_in, void* d_out, int out_size, void* d_ws, size_t ws_size, hipStream_t stream) {
    static int grid = 0;
    if (grid == 0) {
        int dev = 0, cus = 0; (void)hipGetDevice(&dev); (void)hipDeviceGetAttribute(&cus, hipDeviceAttributeMultiprocessorCount, dev);
#if MEGA
        (void)hipFuncSetAttribute((const void*)k_fwd, hipFuncAttributeMaxDynamicSharedMemorySize, LDS_BYTES);
        int per_cu = 0; (void)hipOccupancyMaxActiveBlocksPerMultiprocessor(&per_cu, (const void*)k_fwd, 512, LDS_BYTES);
        if (per_cu < 1) fprintf(stderr, "occupancy query says %d\n", per_cu);
#endif
        grid = cus > 0 ? cus : 256;
        if (n_in != 27 || ws_size < W_END) { fprintf(stderr, "kernel_launch: unexpected n_in %d or ws_size %zu (< %zu)\n", n_in, ws_size, (size_t)W_END); }
    }
    Prm p{};
    const float** f = (const float**)&p;
    for (int i = 0; i < 27; ++i) f[i] = (const float*)d_in[i];
    p.out = (float*)d_out; p.ws = (unsigned char*)d_ws; p.phase = 0; p.pad = 0;
#if MEGA
    void* args[] = {&p};
    hipError_t e = hipLaunchCooperativeKernel((const void*)k_fwd, dim3(grid), dim3(512), args, LDS_BYTES, stream);
    if (e != hipSuccess) fprintf(stderr, "cooperative launch failed: %s\n", hipGetErrorString(e));
#else
    launch_ph<0>(p, grid, stream); launch_ph<1>(p, grid, stream); launch_ph<2>(p, grid, stream); launch_ph<3>(p, grid, stream); launch_ph<4>(p, grid, stream);
    launch_ph<5>(p, grid, stream); launch_ph<6>(p, grid, stream); launch_ph<7>(p, grid, stream); launch_ph<8>(p, grid, stream); launch_ph<9>(p, grid, stream);
    launch_ph<10>(p, grid, stream); launch_ph<11>(p, grid, stream); launch_ph<12>(p, grid, stream); launch_ph<13>(p, grid, stream); launch_ph<14>(p, grid, stream);
#endif
}
```

```cpp
#include <hip/hip_runtime.h>
#include <hip/hip_cooperative_groups.h>
#include <stdint.h>
#include <cstdio>
namespace cg = cooperative_groups;

typedef unsigned short bf16_t;
typedef short bf16x8 __attribute__((ext_vector_type(8)));
typedef short s16x4 __attribute__((ext_vector_type(4)));
typedef float f32x16 __attribute__((ext_vector_type(16)));
typedef float f32x4 __attribute__((ext_vector_type(4)));
typedef float f32x2 __attribute__((ext_vector_type(2)));
typedef unsigned u32x4 __attribute__((ext_vector_type(4)));
typedef unsigned u32x2 __attribute__((ext_vector_type(2)));
typedef __bf16 bf16x2_t __attribute__((ext_vector_type(2)));
#define DI __device__ __forceinline__
#define MFMA32(a, b, c) __builtin_amdgcn_mfma_f32_32x32x16_bf16((a), (b), (c), 0, 0, 0)

#ifndef MEGA
#define MEGA 1
#endif

constexpr int D = 1024, DFF = 2816, NPJ = 2816;
constexpr int M = 35072, ROW_S = 32768, ROW_META = 34816, ROW_PAD = 34880;
constexpr int C_Z = 1536, C_CQ = 2048, C_CKV = 2432, C_KR = 2688, C_A = 2752, C_B = 2756;
constexpr int NKEY_S = 2128;
constexpr int NTB = 2192;
constexpr float QSCALE = 0.07216878364870322f * 1.4426950408889634f;

constexpr size_t O_YS = 33554432, O_PCKV = 35651584, O_PKR = 44056576, O_PGDN = 46157824, O_PCONV = 46419968,
                 O_SCKV = 46438400, O_SKR = 46962688, O_SGDN = 47093760, O_SCONV = 49190912;
constexpr size_t al(size_t x) { return (x + 255) & ~(size_t)255; }
constexpr size_t W_XT = 0;
constexpr size_t W_CTR = al(W_XT + 256 * 1024 * 4);
constexpr size_t W_BAR = al(W_CTR + 4096);
constexpr size_t W_TBL = al(W_BAR + 16384);
constexpr size_t W_RSS = al(W_TBL + (size_t)8208 * 64 * 4);
constexpr size_t W_XN = al(W_RSS + (size_t)2 * M * 16 * 4);
constexpr size_t W_HP = al(W_XN + (size_t)M * 1024 * 2);
constexpr size_t W_WGU1 = al(W_HP + (size_t)M * 2816 * 2);
constexpr size_t W_WD1 = al(W_WGU1 + (size_t)5632 * 1024 * 2);
constexpr size_t W_WIN = al(W_WD1 + (size_t)1024 * 2816 * 2);
constexpr size_t W_HALO = W_WGU1;
constexpr size_t W_WO = al(W_WIN + (size_t)2816 * 1024 * 2);
constexpr size_t W_WUQ = al(W_WO + (size_t)1024 * 1024 * 2);
constexpr size_t W_WKN = al(W_WUQ + (size_t)768 * 384 * 2);
constexpr size_t W_WVT = al(W_WKN + (size_t)512 * 256 * 2);
constexpr size_t W_WUKV = al(W_WVT + (size_t)512 * 256 * 2);
constexpr size_t W_WGU2 = al(W_WUKV + (size_t)256 * 1024 * 2);
constexpr size_t W_WD2 = al(W_WGU2 + (size_t)5632 * 1024 * 2);
constexpr size_t W_Q = al(W_WD2 + (size_t)1024 * 2816 * 2);
constexpr size_t W_KN = al(W_Q + (size_t)M * 768 * 2);
constexpr size_t W_VT = al(W_KN + (size_t)M * 512 * 2);
constexpr size_t EXB = 24832;
constexpr size_t W_EX = al(W_VT + (size_t)M * 512 * 2);
constexpr size_t W_METAX = al(W_EX + (size_t)NTB * EXB);
constexpr size_t W_QS = al(W_METAX + (size_t)16 * 3 * 8192 * 2);
constexpr size_t W_OL = al(W_QS + (size_t)2048 * 1024 * 2);
constexpr size_t W_END = al(W_OL + (size_t)2048 * 1024 * 2);
static_assert((size_t)4 * 129 * 3 * 1536 * 2 <= W_WO - W_WGU1, "halo overlay");
static_assert(W_END <= 536870912ull, "workspace");

constexpr int LDS_BYTES = 147456;

struct Prm {
    const float *x_prompt, *x_sample, *cache_ckv, *cache_kr, *state_gdn, *state_conv, *meta, *ffn1_norm, *ffn1_wg, *ffn1_wu, *ffn1_wd,
        *mix_norm, *w_in, *conv_w, *a_log, *dt_bias, *gdn_norm, *q_norm, *kv_norm, *w_uq, *w_ukv, *w_out, *ffn2_norm, *ffn2_wg, *ffn2_wu,
        *ffn2_wd, *final_norm;
    float* out;
    unsigned char* ws;
    int phase, pad;
};

DI unsigned pk2(float lo, float hi) { f32x2 v = {lo, hi}; bf16x2_t b = __builtin_convertvector(v, bf16x2_t); return __builtin_bit_cast(unsigned, b); }
DI bf16_t f2bf(float f) { return (bf16_t)(pk2(f, 0.f) & 0xffffu); }
DI float bf2f(bf16_t h) { return __uint_as_float(((unsigned)h) << 16); }
DI float bflo(unsigned u) { return __uint_as_float(u << 16); }
DI float bfhi(unsigned u) { return __uint_as_float(u & 0xffff0000u); }
DI float wave_sum(float v) {
    v += __int_as_float(__builtin_amdgcn_update_dpp(0, __float_as_int(v), 0xB1, 0xF, 0xF, true));
    v += __int_as_float(__builtin_amdgcn_update_dpp(0, __float_as_int(v), 0x4E, 0xF, 0xF, true));
    v += __int_as_float(__builtin_amdgcn_update_dpp(0, __float_as_int(v), 0x141, 0xF, 0xF, true));
    v += __int_as_float(__builtin_amdgcn_update_dpp(0, __float_as_int(v), 0x140, 0xF, 0xF, true));
    const float r0 = __int_as_float(__builtin_amdgcn_readlane(__float_as_int(v), 0)), r1 = __int_as_float(__builtin_amdgcn_readlane(__float_as_int(v), 16));
    const float r2 = __int_as_float(__builtin_amdgcn_readlane(__float_as_int(v), 32)), r3 = __int_as_float(__builtin_amdgcn_readlane(__float_as_int(v), 48));
    return (r0 + r1) + (r2 + r3);
}
DI float xhalf_max(float v) { const auto r = __builtin_amdgcn_permlane32_swap(__float_as_uint(v), __float_as_uint(v), false, false); return fmaxf(__uint_as_float(r[0]), __uint_as_float(r[1])); }
DI float xhalf_sum(float v) { const auto r = __builtin_amdgcn_permlane32_swap(__float_as_uint(v), __float_as_uint(v), false, false); return __uint_as_float(r[0]) + __uint_as_float(r[1]); }
DI float row16_sum(float v) {
    v += __int_as_float(__builtin_amdgcn_update_dpp(0, __float_as_int(v), 0xB1, 0xF, 0xF, true));
    v += __int_as_float(__builtin_amdgcn_update_dpp(0, __float_as_int(v), 0x4E, 0xF, 0xF, true));
    v += __int_as_float(__builtin_amdgcn_update_dpp(0, __float_as_int(v), 0x141, 0xF, 0xF, true));
    v += __int_as_float(__builtin_amdgcn_update_dpp(0, __float_as_int(v), 0x140, 0xF, 0xF, true));
    return v;
}
DI float rss_rstd(const float* rss, int r) {
    const f32x4* q = (const f32x4*)(rss + (size_t)r * 16); const f32x4 a = q[0], b = q[1], c = q[2], d = q[3];
    const float ss = ((a.x + a.y) + (a.z + a.w)) + ((b.x + b.y) + (b.z + b.w)) + (((c.x + c.y) + (c.z + c.w)) + ((d.x + d.y) + (d.z + d.w)));
    return rsqrtf(ss * (1.f / 1024.f) + 1e-6f);
}
DI float siluf(float x) { return x * __builtin_amdgcn_rcpf(1.f + __expf(-x)); }
DI float* xrow(const Prm& p, int r) { return r < ROW_META ? p.out + (size_t)r * D : (float*)(p.ws + W_XT) + (size_t)(r - ROW_META) * D; }
DI const float* x0row(const Prm& p, int r) { return r < ROW_S ? p.x_prompt + (size_t)r * D : (r < ROW_META ? p.x_sample + (size_t)(r - ROW_S) * D : (r < ROW_PAD ? p.meta + (size_t)((r - ROW_META) & 15) * D : nullptr)); }
DI int rowpos(int r) { return r < ROW_S ? 16 + (r & 8191) : (r < ROW_META ? 2064 + ((r - ROW_S) & 63) : ((r - ROW_META) & 15)); }
DI bf16x8 packs(const f32x16& x, int s) {
    u32x4 w;
    w.x = pk2(x[8 * s + 0], x[8 * s + 1]); w.y = pk2(x[8 * s + 2], x[8 * s + 3]);
    w.z = pk2(x[8 * s + 4], x[8 * s + 5]); w.w = pk2(x[8 * s + 6], x[8 * s + 7]);
    return __builtin_bit_cast(bf16x8, w);
}
DI bf16x8 ld_perm(const bf16_t* p) {
    s16x4 a = *(const s16x4*)p, b = *(const s16x4*)(p + 8);
    bf16x8 r; r[0] = a[0]; r[1] = a[1]; r[2] = a[2]; r[3] = a[3]; r[4] = b[0]; r[5] = b[1]; r[6] = b[2]; r[7] = b[3];
    return r;
}

template <class F> DI void cvt_w(bf16_t* dst, int K, int Nout, const float* src, int ldsrc, F colmap, int gt, int ngt) {
    const int kc = K / 8; const long items = (long)Nout * kc;
    for (long it = gt; it < items; it += ngt) {
        const int n = (int)(it % Nout), k0 = (int)(it / Nout) * 8; const int c = colmap(n);
        float v[8];
#pragma unroll
        for (int j = 0; j < 8; ++j) v[j] = c >= 0 ? src[(size_t)(k0 + j) * ldsrc + c] : 0.f;
        u32x4 w; w.x = pk2(v[0], v[1]); w.y = pk2(v[2], v[3]); w.z = pk2(v[4], v[5]); w.w = pk2(v[6], v[7]);
        *(u32x4*)(dst + (size_t)n * K + k0) = w;
    }
}
DI void norm_rows(const Prm& p, int mode, const float* gain, int gw, int ngw, int lane) {
    bf16_t* XN = (bf16_t*)(p.ws + W_XN);
    for (int r = gw; r < M; r += ngw) {
        const float* src = nullptr;
        if (mode == 0) { if (r < ROW_S) src = p.x_prompt + (size_t)r * D; else if (r < ROW_META) src = p.x_sample + (size_t)(r - ROW_S) * D; else if (r < ROW_PAD) src = p.meta + (size_t)((r - ROW_META) & 15) * D; }
        else src = xrow(p, r);
        f32x4 v[4]; float ss = 0.f;
#pragma unroll
        for (int j = 0; j < 4; ++j) { v[j] = src ? ((const f32x4*)src)[lane + 64 * j] : (f32x4){0.f, 0.f, 0.f, 0.f}; ss += v[j].x * v[j].x + v[j].y * v[j].y + v[j].z * v[j].z + v[j].w * v[j].w; }
        ss = wave_sum(ss); const float rstd = rsqrtf(ss * (1.f / D) + 1e-6f);
#pragma unroll
        for (int j = 0; j < 4; ++j) { const f32x4 g = ((const f32x4*)gain)[lane + 64 * j]; u32x2 w; w.x = pk2(v[j].x * rstd * g.x, v[j].y * rstd * g.y); w.y = pk2(v[j].z * rstd * g.z, v[j].w * rstd * g.w);
            ((u32x2*)(XN + (size_t)r * D))[lane + 64 * j] = w; }
    }
}
DI void final_norm_rows(const Prm& p, int r0, int r1, int gw, int ngw, int lane, const unsigned (&mask)[5], unsigned want) {
    for (int r = r0 + gw; r < r1; r += ngw) {
        const int pn_ = r >> 8; if (((mask[pn_ >> 5] >> (pn_ & 31)) & 1u) != want) continue;
        float* x = p.out + (size_t)r * D; f32x4 v[4]; float ss = 0.f;
#pragma unroll
        for (int j = 0; j < 4; ++j) { v[j] = ((const f32x4*)x)[lane + 64 * j]; ss += v[j].x * v[j].x + v[j].y * v[j].y + v[j].z * v[j].z + v[j].w * v[j].w; }
        ss = wave_sum(ss); const float rstd = rsqrtf(ss * (1.f / D) + 1e-6f);
#pragma unroll
        for (int j = 0; j < 4; ++j) { const f32x4 g = ((const f32x4*)p.final_norm)[lane + 64 * j]; ((f32x4*)x)[lane + 64 * j] = (f32x4){v[j].x * rstd * g.x, v[j].y * rstd * g.y, v[j].z * rstd * g.z, v[j].w * rstd * g.w}; }
    }
}
DI void cvt_ffn(const Prm& p, int l, int gt, int ngt, int parts = 3) {
    unsigned char* ws = p.ws;
    const float *wg = l ? p.ffn2_wg : p.ffn1_wg, *wu = l ? p.ffn2_wu : p.ffn1_wu, *wd = l ? p.ffn2_wd : p.ffn1_wd;
    bf16_t* dgu = (bf16_t*)(ws + (l ? W_WGU2 : W_WGU1)); bf16_t* dd = (bf16_t*)(ws + (l ? W_WD2 : W_WD1));
    const long du = wu - wg;
    const int kc = D / 8; const long items = (parts & 1) ? (long)5632 * kc : 0;
    for (long it = gt; it < items; it += ngt) { const int n = (int)(it % 5632), k0 = (int)(it / 5632) * 8; const int blk = n >> 8, r = n & 255; const float* s = wg + (r < 128 ? 0l : du); const int c = blk * 128 + (r & 127);
        float v[8];
#pragma unroll
        for (int j = 0; j < 8; ++j) v[j] = s[(size_t)(k0 + j) * DFF + c];
        u32x4 w; w.x = pk2(v[0], v[1]); w.y = pk2(v[2], v[3]); w.z = pk2(v[4], v[5]); w.w = pk2(v[6], v[7]);
        *(u32x4*)(dgu + (size_t)n * D + k0) = w; }
    if (parts & 2) cvt_w(dd, DFF, D, wd, D, [](int n) { return n; }, gt, ngt);
}
DI void prep_late(const Prm& p, int gt, int ngt) {
    unsigned char* ws = p.ws;
    cvt_w((bf16_t*)(ws + W_WIN), D, NPJ, p.w_in, 2760, [](int n) {
        if (n < 2048) return n; if (n < C_KR) return n + 8;
        if (n < C_A) { const int q = n - C_KR; return 2696 + (q >> 1) + 32 * (q & 1); }
        if (n < C_A + 4) return 2048 + (n - C_A); if (n < C_B + 4) return 2052 + (n - C_B); return -1; }, gt, ngt);
    cvt_w((bf16_t*)(ws + W_WO), D, D, p.w_out, D, [](int n) { return n; }, gt, ngt);
    cvt_w((bf16_t*)(ws + W_WUQ), 384, 768, p.w_uq, 768, [](int n) { const int h = n / 192, j = n % 192; if (j < 128) return n; const int q = j - 128; return h * 192 + 128 + (q >> 1) + 32 * (q & 1); }, gt, ngt);
    cvt_w((bf16_t*)(ws + W_WKN), 256, 512, p.w_ukv, 1024, [](int n) { return (n >> 7) * 256 + (n & 127); }, gt, ngt);
    cvt_w((bf16_t*)(ws + W_WVT), 256, 512, p.w_ukv, 1024, [](int n) { return (n >> 7) * 256 + 128 + (n & 127); }, gt, ngt);
    {
        bf16_t* d = (bf16_t*)(ws + W_WUKV);
        for (int i = gt; i < 256 * 1024 / 4; i += ngt) { const f32x4 v = ((const f32x4*)p.w_ukv)[i]; u32x2 w; w.x = pk2(v.x, v.y); w.y = pk2(v.z, v.w); ((u32x2*)d)[i] = w; }
    }
    cvt_ffn(p, 1, gt, ngt);
}
DI void phase_prep(const Prm& p, int tid, int lane, int wid) {
    const int gt = blockIdx.x * 512 + tid, ngt = gridDim.x * 512, gw = blockIdx.x * 8 + wid, ngw = gridDim.x * 8;
    unsigned char* ws = p.ws;
    if (gt < 8) ((unsigned*)(ws + W_CTR))[64 * gt] = 0u;
    cvt_ffn(p, 0, gt, ngt, 1);
    {
        float* tb = (float*)(ws + W_TBL);
        for (int it = gt; it < 8208 * 32; it += ngt) { const int pos = it >> 5, i = it & 31; const float inv = exp2f(-(float)i * (13.287712379549449f / 32.f)); float s, c; sincosf((float)pos * inv, &s, &c); tb[pos * 64 + i] = c; tb[pos * 64 + 32 + i] = s; }
    }
    norm_rows(p, 0, p.ffn1_norm, gw, ngw, lane);
}

template <class Epi> DI void gemm_simple(const bf16_t* A, int lda, const bf16_t* Bt, int ldb, int Mg, int Ng, int K, const Epi& epi, int gw, int ngw, int lane) {
    const int TN = Ng / 64, TM = Mg / 64, lr = lane & 31, hi = lane >> 5;
    for (int idx = gw; idx < TM * TN; idx += ngw) {
        const int tm = idx / TN, tn = idx % TN, m0 = tm * 64, n0 = tn * 64;
        f32x16 acc[2][2];
#pragma unroll
        for (int a = 0; a < 2; ++a)
#pragma unroll
            for (int b = 0; b < 2; ++b)
#pragma unroll
                for (int i = 0; i < 16; ++i) acc[a][b][i] = 0.f;
        const bf16_t* ap = A + (size_t)(m0 + lr) * lda + 8 * hi;
        const bf16_t* bp = Bt + (size_t)(n0 + lr) * ldb + 8 * hi;
        const size_t a32 = (size_t)32 * lda, b32 = (size_t)32 * ldb;
#pragma unroll 4
        for (int k = 0; k < K; k += 16) {
            const bf16x8 a0 = *(const bf16x8*)(ap + k), a1 = *(const bf16x8*)(ap + a32 + k);
            const bf16x8 b0 = *(const bf16x8*)(bp + k), b1 = *(const bf16x8*)(bp + b32 + k);
            acc[0][0] = MFMA32(b0, a0, acc[0][0]); acc[0][1] = MFMA32(b1, a0, acc[0][1]);
            acc[1][0] = MFMA32(b0, a1, acc[1][0]); acc[1][1] = MFMA32(b1, a1, acc[1][1]);
        }
        epi(acc, m0, n0, lr, hi);
    }
}
struct EpiGU {
    bf16_t* H;
    DI void operator()(const f32x16 (&acc)[2][2], int m0, int n0, int lr, int hi) const {
#pragma unroll
        for (int mi = 0; mi < 2; ++mi) { bf16_t* row = H + (size_t)(m0 + 32 * mi + lr) * DFF + (n0 >> 1) + 4 * hi;
#pragma unroll
            for (int g = 0; g < 4; ++g) { float v[4];
#pragma unroll
                for (int e = 0; e < 4; ++e) v[e] = siluf(acc[mi][0][4 * g + e]) * acc[mi][1][4 * g + e];
                u32x2 w; w.x = pk2(v[0], v[1]); w.y = pk2(v[2], v[3]); *(u32x2*)(row + 8 * g) = w; } }
    }
};
struct EpiRes {
    Prm p; float alpha;
    DI void operator()(const f32x16 (&acc)[2][2], int m0, int n0, int lr, int hi) const {
#pragma unroll
        for (int mi = 0; mi < 2; ++mi) { float* row = xrow(p, m0 + 32 * mi + lr) + n0 + 4 * hi;
#pragma unroll
            for (int ni = 0; ni < 2; ++ni)
#pragma unroll
                for (int g = 0; g < 4; ++g) { f32x4* q = (f32x4*)(row + 32 * ni + 8 * g); f32x4 x = *q;
                    x.x += alpha * acc[mi][ni][4 * g]; x.y += alpha * acc[mi][ni][4 * g + 1]; x.z += alpha * acc[mi][ni][4 * g + 2]; x.w += alpha * acc[mi][ni][4 * g + 3]; *q = x; } }
    }
};
struct EpiBf {
    bf16_t* O; int ldc;
    DI void operator()(const f32x16 (&acc)[2][2], int m0, int n0, int lr, int hi) const {
#pragma unroll
        for (int mi = 0; mi < 2; ++mi) { bf16_t* row = O + (size_t)(m0 + 32 * mi + lr) * ldc + n0 + 4 * hi;
#pragma unroll
            for (int ni = 0; ni < 2; ++ni)
#pragma unroll
                for (int g = 0; g < 4; ++g) { u32x2 w; w.x = pk2(acc[mi][ni][4 * g], acc[mi][ni][4 * g + 1]); w.y = pk2(acc[mi][ni][4 * g + 2], acc[mi][ni][4 * g + 3]); *(u32x2*)(row + 32 * ni + 8 * g) = w; } }
    }
};
struct EpiQ {
    bf16_t* Q; const float* tbl;
    DI void operator()(const f32x16 (&acc)[2][2], int m0, int n0, int lr, int hi) const {
        const bool rope = ((n0 >> 6) % 3) == 2;
#pragma unroll
        for (int mi = 0; mi < 2; ++mi) { const int r = m0 + 32 * mi + lr; bf16_t* row = Q + (size_t)r * 768 + n0 + 4 * hi; const float* tb = tbl + (size_t)rowpos(r) * 64;
#pragma unroll
            for (int ni = 0; ni < 2; ++ni)
#pragma unroll
                for (int g = 0; g < 4; ++g) { float v0 = acc[mi][ni][4 * g], v1 = acc[mi][ni][4 * g + 1], v2 = acc[mi][ni][4 * g + 2], v3 = acc[mi][ni][4 * g + 3];
                    if (rope) { const int i0 = (32 * ni + 8 * g + 4 * hi) >> 1; const float c0 = tb[i0], s0 = tb[32 + i0], c1 = tb[i0 + 1], s1 = tb[33 + i0];
                        const float a0 = v0 * c0 - v1 * s0, b0 = v1 * c0 + v0 * s0, a1 = v2 * c1 - v3 * s1, b1 = v3 * c1 + v2 * s1; v0 = a0; v1 = b0; v2 = a1; v3 = b1; }
                    u32x2 w; w.x = pk2(v0 * QSCALE, v1 * QSCALE); w.y = pk2(v2 * QSCALE, v3 * QSCALE); *(u32x2*)(row + 32 * ni + 8 * g) = w; } }
    }
};

DI void phase_post(const Prm& p, int gw, int ngw, int lane) {
    bf16_t* HP = (bf16_t*)(p.ws + W_HP); bf16_t* halo = (bf16_t*)(p.ws + W_HALO); const float* tbl = (const float*)(p.ws + W_TBL);
    for (int r = gw; r < ROW_PAD; r += ngw) {
        bf16_t* row = HP + (size_t)r * NPJ;
        int ck_row, sidx = -1;
        float *ockv, *okr;
        if (r < ROW_S) { const int b = r >> 13, t = r & 8191; ck_row = b * 8208 + 16 + t; ockv = p.out + O_PCKV + (size_t)ck_row * 256; okr = p.out + O_PKR + (size_t)ck_row * 64; }
        else if (r < ROW_META) { sidx = r - ROW_S; ockv = p.out + O_SCKV + (size_t)sidx * 256; okr = p.out + O_SKR + (size_t)sidx * 64; }
        else { const int b = (r - ROW_META) >> 4, i = (r - ROW_META) & 15; ck_row = b * 8208 + i; ockv = p.out + O_PCKV + (size_t)ck_row * 256; okr = p.out + O_PKR + (size_t)ck_row * 64; }
        { unsigned* q = (unsigned*)(row + C_CQ); unsigned u[3]; float ss = 0.f;
#pragma unroll
          for (int j = 0; j < 3; ++j) { u[j] = q[lane + 64 * j]; const float a = bflo(u[j]), b = bfhi(u[j]); ss += a * a + b * b; }
          ss = wave_sum(ss); const float rstd = rsqrtf(ss * (1.f / 384.f) + 1e-6f);
#pragma unroll
          for (int j = 0; j < 3; ++j) { const int c = 2 * (lane + 64 * j); q[lane + 64 * j] = pk2(bflo(u[j]) * rstd * p.q_norm[c], bfhi(u[j]) * rstd * p.q_norm[c + 1]); } }
        { u32x2* q = (u32x2*)(row + C_CKV) + lane; const u32x2 u = *q; float v[4] = {bflo(u.x), bfhi(u.x), bflo(u.y), bfhi(u.y)};
          float ss = v[0] * v[0] + v[1] * v[1] + v[2] * v[2] + v[3] * v[3]; ss = wave_sum(ss); const float rstd = rsqrtf(ss * (1.f / 256.f) + 1e-6f);
          const f32x4 g = ((const f32x4*)p.kv_norm)[lane]; f32x4 c = {v[0] * rstd * g.x, v[1] * rstd * g.y, v[2] * rstd * g.z, v[3] * rstd * g.w};
          ((f32x4*)ockv)[lane] = c; u32x2 w; w.x = pk2(c.x, c.y); w.y = pk2(c.z, c.w); *q = w; }
        if (lane < 32) { unsigned* q = (unsigned*)(row + C_KR) + lane; const unsigned u = *q; const float x1 = bflo(u), x2 = bfhi(u); const float* tb = tbl + (size_t)rowpos(r) * 64; const float c = tb[lane], s = tb[32 + lane];
            const float o1 = x1 * c - x2 * s, o2 = x2 * c + x1 * s; okr[lane] = o1; okr[32 + lane] = o2; const unsigned w = pk2(o1, o2); *q = w; }
        { int hb = -1, hc = 0, hj = 0;
          if (r < ROW_S) { const int t = r & 8191; if ((t & 63) >= 61 && t < 8128) { hb = r >> 13; hc = (t >> 6) + 2; hj = (t & 63) - 61; } }
          else if (r >= ROW_META && ((r - ROW_META) & 15) >= 13) { hb = (r - ROW_META) >> 4; hc = 1; hj = ((r - ROW_META) & 15) - 13; }
          if (hb >= 0) { unsigned* hd = (unsigned*)(halo + (((size_t)hb * 129 + hc) * 3 + hj) * 1536); for (int c = lane; c < 768; c += 64) hd[c] = ((const unsigned*)row)[c]; } }
        if (r < ROW_S && (r & 8191) >= 8189) { float* o = p.out + O_PCONV + ((size_t)(r >> 13) * 3 + ((r & 8191) - 8189)) * 1536;
            for (int c = lane; c < 768; c += 64) { const unsigned u = ((const unsigned*)row)[c]; o[2 * c] = bflo(u); o[2 * c + 1] = bfhi(u); } }
        if (sidx >= 0 && (sidx & 63) >= 61) { float* o = p.out + O_SCONV + ((size_t)(sidx >> 6) * 3 + ((sidx & 63) - 61)) * 1536;
            for (int c = lane; c < 768; c += 64) { const unsigned u = ((const unsigned*)row)[c]; o[2 * c] = bflo(u); o[2 * c + 1] = bfhi(u); } }
    }
}

DI f32x2 gdn_raw(const Prm& p, int kind, int b, int c, int t_rel, int col) {
    const bf16_t* HP = (const bf16_t*)(p.ws + W_HP); int row;
    if (kind == 0) {
        if (t_rel < 0) { if (c == 0) return (f32x2){0.f, 0.f}; const unsigned u = *(const unsigned*)((const bf16_t*)(p.ws + W_HALO) + (((size_t)b * 129 + c) * 3 + (3 + t_rel)) * 1536 + col); return (f32x2){bflo(u), bfhi(u)}; }
        row = c == 0 ? ROW_META + 16 * b + t_rel : b * 8192 + 64 * (c - 1) + t_rel;
    } else {
        if (t_rel < 0) { const float* s = p.state_conv + ((size_t)b * 3 + (3 + t_rel)) * 1536 + col; return (f32x2){s[0], s[1]}; }
        row = ROW_S + 64 * b + t_rel;
    }
    const unsigned u = *(const unsigned*)(HP + (size_t)row * NPJ + col); return (f32x2){bflo(u), bfhi(u)};
}
DI bf16_t* gdn_slot(const Prm& p, int kind, int b, int c, int h, int which, int& ld) {
    if (kind == 0 && c == 0) { ld = 128; return (bf16_t*)(p.ws + W_METAX) + ((size_t)(b * 4 + h) * 3 + which) * 8192; }
    ld = NPJ; const int row0 = kind == 0 ? b * 8192 + 64 * (c - 1) : ROW_S + 64 * b; return (bf16_t*)(p.ws + W_HP) + (size_t)row0 * NPJ + which * 512 + h * 128;
}
DI int gdn_row(int kind, int b, int c, int t) { return kind == 0 ? (c == 0 ? ROW_META + 16 * b + t : b * 8192 + 64 * (c - 1) + t) : ROW_S + 64 * b + t; }
DI void gdn_gates(const Prm& p, int kind, int b, int c, int h, int lane, float& gc, float& beta) {
    const bf16_t* HP = (const bf16_t*)(p.ws + W_HP); const int ntok = (kind == 0 && c == 0) ? 16 : 64;
    float g = 0.f; beta = 0.f;
    if (lane < ntok) { const bf16_t* row = HP + (size_t)gdn_row(kind, b, c, lane) * NPJ; const float a = bf2f(row[C_A + h]), bb = bf2f(row[C_B + h]);
        const float x = a + p.dt_bias[h]; const float sp = fmaxf(x, 0.f) + __logf(1.f + __expf(-fabsf(x))); g = -__expf(p.a_log[h]) * sp; beta = __builtin_amdgcn_rcpf(1.f + __expf(-bb)); }
#define GDN_DPP_ADD(ctrl, rmask) g += __int_as_float(__builtin_amdgcn_update_dpp(0, __float_as_int(g), ctrl, rmask, 0xF, false))
    GDN_DPP_ADD(0x111, 0xF); GDN_DPP_ADD(0x112, 0xF); GDN_DPP_ADD(0x114, 0xF); GDN_DPP_ADD(0x118, 0xF);
    GDN_DPP_ADD(0x142, 0xA);
    GDN_DPP_ADD(0x143, 0xC);
#undef GDN_DPP_ADD
    gc = g;
}
template <class F> DI void gdn_conv(const Prm& p, int kind, int b, int c, int col, int t0, int n, F f) {
    f32x2 w[4];
#pragma unroll
    for (int j = 0; j < 4; ++j) w[j] = (f32x2){p.conv_w[j * 1536 + col], p.conv_w[j * 1536 + col + 1]};
    f32x2 x0 = gdn_raw(p, kind, b, c, t0 - 3, col), x1 = gdn_raw(p, kind, b, c, t0 - 2, col), x2 = gdn_raw(p, kind, b, c, t0 - 1, col);
#pragma unroll 8
    for (int t = t0; t < t0 + n; ++t) { const f32x2 x3 = gdn_raw(p, kind, b, c, t, col);
        const float y0 = w[0].x * x0.x + w[1].x * x1.x + w[2].x * x2.x + w[3].x * x3.x, y1 = w[0].y * x0.y + w[1].y * x1.y + w[2].y * x2.y + w[3].y * x3.y;
        f(t, siluf(y0), siluf(y1)); x0 = x1; x1 = x2; x2 = x3; }
}
DI void gdn_unit_decode(int u, int& kind, int& b, int& c, int& h) { if (u < 2064) { kind = 0; b = u / 516; const int r = u % 516; c = r >> 2; h = r & 3; } else { kind = 1; b = (u - 2064) >> 2; c = 0; h = u & 3; } }

constexpr int GK_STR = 136;
constexpr int GT_STR = 72;
constexpr int GP_Q = 0, GP_K = 17408, GP_KEG = 34816, GP_VT = 53248, GP_KD = 71680, GP_TB = 90112, GP_A = 99328, GP_G = 115712;
DI void gdn_pre_unit(const Prm& p, unsigned char* lds0, int u, int tid, int wid, int lane) {
    int loff = 0; asm volatile("" : "+s"(loff)); unsigned char* lds = lds0 + loff;
    bf16_t* qL = (bf16_t*)(lds + GP_Q); bf16_t* kL = (bf16_t*)(lds + GP_K); bf16_t* kegL = (bf16_t*)(lds + GP_KEG); bf16_t* vtL = (bf16_t*)(lds + GP_VT); bf16_t* kdL = (bf16_t*)(lds + GP_KD);
    bf16_t* tbL = (bf16_t*)(lds + GP_TB); float* AL = (float*)(lds + GP_A); float* gL = (float*)(lds + GP_G);
    unsigned char* ex = p.ws + W_EX + (size_t)u * EXB;
    int kind, b, c, h; gdn_unit_decode(u, kind, b, c, h);
    const int lr = lane & 31, hi = lane >> 5;
    __syncthreads();
    if (wid == 0) { float gc, beta; gdn_gates(p, kind, b, c, h, lane, gc, beta); gL[lane] = gc; gL[64 + lane] = beta; const float eg = __expf(gc); gL[128 + lane] = eg; ((float*)(ex + 24576))[lane] = eg; }
    __syncthreads();
    const float gl = gL[63];
    if (wid < 6) { const int part = wid % 3, th = wid / 3;
        gdn_conv(p, kind, b, c, part * 512 + h * 128 + 2 * lane, 32 * th, 32, [&](int t, float y0, float y1) {
            if (part == 2) { vtL[(2 * lane) * GT_STR + t] = f2bf(y0); vtL[(2 * lane + 1) * GT_STR + t] = f2bf(y1); }
            else { const float ss = wave_sum(y0 * y0 + y1 * y1); float rn = rsqrtf(ss + 1e-6f);
                if (part == 0) { rn *= 0.08838834764831845f; *(unsigned*)(qL + t * GK_STR + 2 * lane) = pk2(y0 * rn, y1 * rn); }
                else { const float k0 = y0 * rn, k1 = y1 * rn; *(unsigned*)(kL + t * GK_STR + 2 * lane) = pk2(k0, k1); const float eg = gL[128 + t], ed = __expf(gl - gL[t]);
                    kegL[(2 * lane) * GT_STR + t] = f2bf(k0 * eg); kegL[(2 * lane + 1) * GT_STR + t] = f2bf(k1 * eg); kdL[(2 * lane) * GT_STR + t] = f2bf(k0 * ed); kdL[(2 * lane + 1) * GT_STR + t] = f2bf(k1 * ed); } } });
    }
    __syncthreads();
    if (wid < 6) {
        const int q = wid % 3, tb = q ? 1 : 0, sb = q == 2 ? 1 : 0; const bf16_t* aL = wid < 3 ? kL : qL;
        f32x16 acc;
#pragma unroll
        for (int i = 0; i < 16; ++i) acc[i] = 0.f;
#pragma unroll
        for (int ks = 0; ks < 8; ++ks) { const bf16x8 a = *(const bf16x8*)(aL + (32 * tb + lr) * GK_STR + 16 * ks + 8 * hi), bb = *(const bf16x8*)(kL + (32 * sb + lr) * GK_STR + 16 * ks + 8 * hi); acc = MFMA32(a, bb, acc); }
        const int s_ = 32 * sb + lr; const float gs = gL[s_];
        if (wid < 3) {
            const int sp = (s_ & 3) * 16 + (s_ >> 2), sp2 = ((32 + lr) & 3) * 16 + ((32 + lr) >> 2);
#pragma unroll
            for (int i = 0; i < 16; ++i) { const int t = 32 * tb + (i & 3) + 8 * (i >> 2) + 4 * hi; AL[t * 64 + sp] = (s_ < t) ? gL[64 + t] * acc[i] * __expf(gL[t] - gs) : 0.f; if (q == 0) AL[t * 64 + sp2] = 0.f; }
        } else { bf16_t* qk = (bf16_t*)(ex + 16384);
#pragma unroll
            for (int i = 0; i < 16; ++i) { const int t = 32 * tb + (i & 3) + 8 * (i >> 2) + 4 * hi; qk[t * 64 + s_] = f2bf(s_ <= t ? acc[i] * __expf(gL[t] - gs) : 0.f); if (q == 0) qk[t * 64 + 32 + lr] = 0; }
        }
    }
    __syncthreads();
    if (wid < 4) {
        const int c = 16 * wid + (lane >> 2), pp = lane & 3; const float beta = gL[64 + c];
        float Tp[16];
#pragma unroll
        for (int j = 0; j < 16; ++j) Tp[j] = 0.f;
#pragma unroll
        for (int t = 0; t < 64; ++t) { float a = 0.f;
#pragma unroll
            for (int j4 = 0; j4 < (t + 15) / 16; ++j4) { const f32x4 av = *(const f32x4*)(AL + t * 64 + pp * 16 + 4 * j4);
                a += av.x * Tp[4 * j4]; a += av.y * Tp[4 * j4 + 1]; a += av.z * Tp[4 * j4 + 2]; a += av.w * Tp[4 * j4 + 3]; }
            a += __int_as_float(__builtin_amdgcn_update_dpp(0, __float_as_int(a), 0xB1, 0xF, 0xF, true));
            a += __int_as_float(__builtin_amdgcn_update_dpp(0, __float_as_int(a), 0x4E, 0xF, 0xF, true));
            const float Tt = (t == c ? 1.f : 0.f) - a;
            if (pp == (t & 3)) Tp[t >> 2] = Tt;
            if (pp == 0) tbL[t * GT_STR + c] = f2bf(Tt * beta);
        }
    }
    __syncthreads();
    {
        f32x16 uu[2];
#pragma unroll
        for (int tb = 0; tb < 2; ++tb)
#pragma unroll
            for (int i = 0; i < 16; ++i) uu[tb][i] = 0.f;
        const bf16_t* bsrc = (wid < 4 ? vtL : kegL) + (32 * (wid & 3) + lr) * GT_STR + 8 * hi;
#pragma unroll
        for (int ks = 0; ks < 4; ++ks) { const bf16x8 bf = *(const bf16x8*)(bsrc + 16 * ks);
            const bf16x8 a0 = *(const bf16x8*)(tbL + lr * GT_STR + 16 * ks + 8 * hi), a1 = *(const bf16x8*)(tbL + (32 + lr) * GT_STR + 16 * ks + 8 * hi);
            uu[0] = MFMA32(a0, bf, uu[0]); uu[1] = MFMA32(a1, bf, uu[1]); }
        if (wid < 4) {
#pragma unroll
            for (int tb = 0; tb < 2; ++tb) { u32x4* d = (u32x4*)(ex + ((size_t)((wid * 2 + tb) * 64 + lane)) * 32);
                d[0] = __builtin_bit_cast(u32x4, packs(uu[tb], 0)); d[1] = __builtin_bit_cast(u32x4, packs(uu[tb], 1)); }
        } else { int ld; bf16_t* wg = gdn_slot(p, kind, b, c, h, 1, ld);
#pragma unroll
            for (int tb = 0; tb < 2; ++tb)
#pragma unroll
                for (int i = 0; i < 16; ++i) { const int t = 32 * tb + (i & 3) + 8 * (i >> 2) + 4 * hi; wg[(size_t)t * ld + 32 * (wid & 3) + lr] = f2bf(-uu[tb][i]); }
        }
    }
    {
        int ld; bf16_t* qg = gdn_slot(p, kind, b, c, h, 0, ld); bf16_t* kg = gdn_slot(p, kind, b, c, h, 2, ld);
#pragma unroll
        for (int i = 0; i < 2; ++i) { const int e = tid + 512 * i, row = e >> 4, cc = e & 15; *(u32x4*)(qg + (size_t)row * ld + 8 * cc) = *(const u32x4*)(qL + row * GK_STR + 8 * cc);
            const int dk = 2 * row + (cc >> 3); *(u32x4*)(kg + (size_t)row * ld + 8 * cc) = *(const u32x4*)(kdL + dk * GT_STR + 8 * (cc & 7)); }
    }
}
DI void phase_gdn_pre(const Prm& p, unsigned char* lds, int tid, int wid, int lane) {
    for (int u = blockIdx.x; u < NTB; u += gridDim.x) { int lv = lane, tv = tid; asm volatile("" : "+v"(lv), "+v"(tv)); gdn_pre_unit(p, lds, u, tv, wid, lv); }
    __syncthreads();
}

constexpr int GS_Q = 0, GS_W = 17408, GS_KD = 34816, GS_QK = 53248, GS_EG = 62464;
DI void gdn_scan_unit(const Prm& p, unsigned char* lds, int kind, int b, int h, int tid, int wid, int lane) {
    bf16_t* O = (bf16_t*)(p.ws + W_XN);
    const int lr = lane & 31, hi = lane >> 5, nch = kind == 0 ? 129 : 1;
    f32x16 Mst[4];
    const int dv = 32 * (wid & 3) + lr;
    constexpr int GS_BUF = 62720;
    u32x4 lsE[14], lsO[14], u0E[4], u0O[4]; float egE = 0.f, egO = 0.f;
    const int lt = tid - 256;
    auto lissue = [&](int c, u32x4 (&ls)[14], float& eg) {
        if (c >= nch) return;
        const int u = kind == 0 ? b * 516 + c * 4 + h : 2064 + b * 4 + h; const unsigned char* ex = p.ws + W_EX + (size_t)u * EXB;
        int ld; const bf16_t* qg = gdn_slot(p, kind, b, c, h, 0, ld); const bf16_t* wg = gdn_slot(p, kind, b, c, h, 1, ld); const bf16_t* kg = gdn_slot(p, kind, b, c, h, 2, ld);
#pragma unroll
        for (int i = 0; i < 4; ++i) { const int e = lt + 256 * i, row = e >> 4, cc = e & 15; ls[i] = *(const u32x4*)(qg + (size_t)row * ld + 8 * cc); ls[4 + i] = *(const u32x4*)(wg + (size_t)row * ld + 8 * cc); ls[8 + i] = *(const u32x4*)(kg + (size_t)row * ld + 8 * cc); }
#pragma unroll
        for (int i = 0; i < 2; ++i) ls[12 + i] = *(const u32x4*)(ex + 16384 + (size_t)(lt + 256 * i) * 16);
        if (lt < 64) eg = ((const float*)(ex + 24576))[lt];
    };
    auto lstore = [&](int buf, const u32x4 (&ls)[14], float eg) {
        unsigned char* lb = lds + buf * GS_BUF; bf16_t* qB = (bf16_t*)(lb + GS_Q); bf16_t* wB = (bf16_t*)(lb + GS_W); bf16_t* kB = (bf16_t*)(lb + GS_KD); bf16_t* qkB = (bf16_t*)(lb + GS_QK);
#pragma unroll
        for (int i = 0; i < 4; ++i) { const int e = lt + 256 * i, row = e >> 4, cc = e & 15; *(u32x4*)(qB + row * GK_STR + 8 * cc) = ls[i]; *(u32x4*)(wB + row * GK_STR + 8 * cc) = ls[4 + i];
            const int dk = 2 * row + (cc >> 3); *(u32x4*)(kB + dk * GT_STR + 8 * (cc & 7)) = ls[8 + i]; }
#pragma unroll
        for (int i = 0; i < 2; ++i) { const int e = lt + 256 * i, row = e >> 3, cc = e & 7; *(u32x4*)(qkB + row * GT_STR + 8 * cc) = ls[12 + i]; }
        if (lt < 64) ((float*)(lb + GS_EG))[lt] = eg;
    };
    auto uissue = [&](int c, u32x4 (&u0)[4]) {
        if (c >= nch) return;
        const int u = kind == 0 ? b * 516 + c * 4 + h : 2064 + b * 4 + h; const unsigned char* ex = p.ws + W_EX + (size_t)u * EXB;
#pragma unroll
        for (int j = 0; j < 4; ++j) u0[j] = *(const u32x4*)(ex + ((size_t)((wid * 2 + (j >> 1)) * 64 + lane)) * 32 + 16 * (j & 1));
    };
    auto lchunk = [&](int c, u32x4 (&lsn)[14], float& egn) {
        if (c + 1 < nch) { lstore((c + 1) & 1, lsn, egn); lissue(c + 3, lsn, egn); }
        __syncthreads();
    };
    auto chunk = [&](int c, u32x4 (&u0)[4]) {
        const int ntok = (kind == 0 && c == 0) ? 16 : 64;
        int lrv = lr, hiv = hi; asm volatile("" : "+v"(lrv), "+v"(hiv));
        const unsigned char* lb = lds + (c & 1) * GS_BUF;
        const bf16_t* qL = (const bf16_t*)(lb + GS_Q); const bf16_t* wL = (const bf16_t*)(lb + GS_W); const bf16_t* kdL = (const bf16_t*)(lb + GS_KD); const bf16_t* qkL = (const bf16_t*)(lb + GS_QK); const float* egL = (const float*)(lb + GS_EG);
        f32x16 uu[2];
#pragma unroll
        for (int tb = 0; tb < 2; ++tb)
#pragma unroll
            for (int q = 0; q < 8; ++q) { const unsigned w = ((const unsigned*)&u0[2 * tb + (q >> 2)])[q & 3]; uu[tb][2 * q] = bflo(w); uu[tb][2 * q + 1] = bfhi(w); }
        uissue(c + 2, u0);
        {
            f32x16 oo[2];
#pragma unroll
            for (int tb = 0; tb < 2; ++tb)
#pragma unroll
                for (int i = 0; i < 16; ++i) oo[tb][i] = 0.f;
            auto loadg = [&](int g, bf16x8 (&f)[4]) {
                if (g < 8) { f[0] = ld_perm(wL + lrv * GK_STR + 16 * g + 4 * hiv); f[1] = ld_perm(wL + (32 + lrv) * GK_STR + 16 * g + 4 * hiv); f[2] = ld_perm(qL + lrv * GK_STR + 16 * g + 4 * hiv); f[3] = ld_perm(qL + (32 + lrv) * GK_STR + 16 * g + 4 * hiv); }
                else if (g < 10) {
#pragma unroll
                    for (int ks = 0; ks < 4; ++ks) f[ks] = ld_perm(qkL + (32 * (g - 8) + lrv) * GT_STR + 16 * ks + 4 * hiv); }
                else {
#pragma unroll
                    for (int ks = 0; ks < 4; ++ks) f[ks] = ld_perm(kdL + (32 * (g - 10) + lrv) * GT_STR + 16 * ks + 4 * hiv); } };
            bf16x8 fa[4], fb[4], ub[4];
            const float egl = egL[63];
            loadg(0, fa);
            __builtin_amdgcn_sched_group_barrier(0x100, 4, 0);
#pragma unroll
            for (int g = 0; g < 14; ++g) {
                bf16x8 (&cur)[4] = (g & 1) ? fb : fa; bf16x8 (&nxt)[4] = (g & 1) ? fa : fb;
                if (g + 1 < 14) loadg(g + 1, nxt);
                if (g < 8) { const bf16x8 mbf = packs(Mst[g >> 1], g & 1);
                    uu[0] = MFMA32(cur[0], mbf, uu[0]); uu[1] = MFMA32(cur[1], mbf, uu[1]); oo[0] = MFMA32(cur[2], mbf, oo[0]); oo[1] = MFMA32(cur[3], mbf, oo[1]);
                    if (g == 7) {
#pragma unroll
                        for (int tb = 0; tb < 2; ++tb)
#pragma unroll
                            for (int i = 0; i < 16; ++i) oo[tb][i] *= egL[32 * tb + (i & 3) + 8 * (i >> 2) + 4 * hiv];
#pragma unroll
                        for (int ks = 0; ks < 4; ++ks) ub[ks] = packs(uu[ks >> 1], ks & 1); }
                } else if (g < 10) {
#pragma unroll
                    for (int ks = 0; ks < 4; ++ks) oo[g - 8] = MFMA32(cur[ks], ub[ks], oo[g - 8]);
                } else {
#pragma unroll
                    for (int i = 0; i < 16; ++i) Mst[g - 10][i] *= egl;
#pragma unroll
                    for (int ks = 0; ks < 4; ++ks) Mst[g - 10] = MFMA32(cur[ks], ub[ks], Mst[g - 10]);
                }
                if (g + 1 < 14) __builtin_amdgcn_sched_group_barrier(0x100, 4, 0);
                __builtin_amdgcn_sched_group_barrier(0x008, 4, 0);
            }
            { bf16_t* ob = O + (size_t)(gdn_row(kind, b, c, 0) + 4 * hiv) * D + h * 128 + dv;
              if (ntok == 64) {
#pragma unroll
                for (int tb = 0; tb < 2; ++tb)
#pragma unroll
                    for (int i = 0; i < 16; ++i) ob[(size_t)(32 * tb + (i & 3) + 8 * (i >> 2)) * D] = f2bf(oo[tb][i]);
              } else {
#pragma unroll
                for (int i = 0; i < 8; ++i) ob[(size_t)((i & 3) + 8 * (i >> 2)) * D] = f2bf(oo[0][i]);
              } }
        }
        __syncthreads();
    };
    if (wid >= 4) {
        lissue(0, lsE, egE); lstore(0, lsE, egE); lissue(1, lsO, egO); lissue(2, lsE, egE);
        __syncthreads();
        for (int c = 0; c < nch; c += 2) { lchunk(c, lsO, egO); if (c + 1 < nch) lchunk(c + 1, lsE, egE); }
    } else {
#pragma unroll
    for (int mb = 0; mb < 4; ++mb)
#pragma unroll
        for (int i = 0; i < 16; ++i) { const int dk = 32 * mb + (i & 3) + 8 * (i >> 2) + 4 * hi; Mst[mb][i] = (kind == 1) ? p.state_gdn[(((size_t)b * 4 + h) * 128 + dk) * 128 + dv] : 0.f; }
        uissue(0, u0E); uissue(1, u0O);
        __syncthreads();
        for (int c = 0; c < nch; c += 2) { chunk(c, u0E); if (c + 1 < nch) chunk(c + 1, u0O); }
        float* so = kind == 0 ? p.out + O_PGDN + ((size_t)b * 4 + h) * 16384 : p.out + O_SGDN + ((size_t)b * 4 + h) * 16384;
#pragma unroll
        for (int mb = 0; mb < 4; ++mb)
#pragma unroll
            for (int i = 0; i < 16; ++i) { const int dk = 32 * mb + (i & 3) + 8 * (i >> 2) + 4 * hi; so[dk * 128 + dv] = Mst[mb][i]; }
    }
    __syncthreads();
}

template <int DN, int QREG  , bool SAMPLE> DI void attn_unit(unsigned char* lds, const bf16_t* qa_row, const bf16_t* qr_row, const bf16_t* k1, int ldk1, const bf16_t* k2, int ldk2,
                                    const bf16_t* vt, int ldvt, int r0, int r1, int ntiles, int tmax_w, bf16_t* orow, bool store, int tid, int lane,
                                    const float* cckv = nullptr, const float* ckr = nullptr, int ps = 0) {
    constexpr int NKS = (DN + 64) / 16, KSTR = DN + 72, CPR = (DN + 64) / 8, NKC = 64 * CPR / 512, VSTR = 68;
    const int lr = lane & 31, hi = lane >> 5;
    constexpr int NQF = QREG == 1 ? NKS : (QREG == 2 ? DN / 16 : 4);
    bf16x8 qf[NQF];
#pragma unroll
    for (int ks = 0; ks < NKS; ++ks) { if (QREG == 1) qf[ks] = (16 * ks < DN) ? *(const bf16x8*)(qa_row + 16 * ks + 8 * hi) : *(const bf16x8*)(qr_row + (16 * ks - DN) + 8 * hi);
        else if (QREG == 2) { if (16 * ks < DN) qf[ks] = *(const bf16x8*)(qa_row + 16 * ks + 8 * hi); }
        else if (16 * ks >= DN) qf[ks - DN / 16] = *(const bf16x8*)(qr_row + (16 * ks - DN) + 8 * hi); }
    f32x16 oacc[4];
#pragma unroll
    for (int d = 0; d < 4; ++d)
#pragma unroll
        for (int i = 0; i < 16; ++i) oacc[d][i] = 0.f;
    float mrun = -INFINITY, lrun = 0.f;
    u32x4 kreg[SAMPLE ? 1 : NKC], vreg[2];
    constexpr int BUFB = 64 * KSTR * 2 + 128 * VSTR * 2;
    auto gload = [&](int t) { const int rb = t == 0 ? r0 : r1 + 64 * (t - 1);
#pragma unroll
        for (int i = 0; i < NKC; ++i) { const int e = tid + 512 * i, row = e / CPR, cc = e % CPR;
            kreg[i] = cc < DN / 8 ? *(const u32x4*)(k1 + (size_t)(rb + row) * ldk1 + 8 * cc) : *(const u32x4*)(k2 + (size_t)(rb + row) * ldk2 + 8 * (cc - DN / 8)); }
#pragma unroll
        for (int i = 0; i < 2; ++i) { const int e = tid + 512 * i, d = e >> 3, cc = e & 7; vreg[i] = *(const u32x4*)(vt + (size_t)d * ldvt + rb + 8 * cc); } };
    auto lstore = [&](int buf) { bf16_t* Kb = (bf16_t*)(lds + buf * BUFB); bf16_t* Vb = (bf16_t*)(lds + buf * BUFB + 64 * KSTR * 2);
#pragma unroll
        for (int i = 0; i < NKC; ++i) { const int e = tid + 512 * i, row = e / CPR, cc = e % CPR; *(u32x4*)(Kb + row * KSTR + 8 * cc) = kreg[i]; }
#pragma unroll
        for (int i = 0; i < 2; ++i) { const int e = tid + 512 * i, d = e >> 3, cc = e & 7; u32x2* q = (u32x2*)(Vb + d * VSTR + 8 * cc); q[0] = (u32x2){vreg[i].x, vreg[i].y}; q[1] = (u32x2){vreg[i].z, vreg[i].w}; } };
    auto compute = [&](const bf16_t* Kt, const bf16_t* Vt, int t) {
        f32x16 s0, s1;
#pragma unroll
        for (int i = 0; i < 16; ++i) { s0[i] = 0.f; s1[i] = 0.f; }
        if (QREG == 1 && !SAMPLE) {
            bf16x8 ka[3][2];
#pragma unroll
            for (int j = 0; j < 2; ++j) { ka[j][0] = *(const bf16x8*)(Kt + lr * KSTR + 16 * j + 8 * hi); ka[j][1] = *(const bf16x8*)(Kt + (32 + lr) * KSTR + 16 * j + 8 * hi); }
            __builtin_amdgcn_sched_group_barrier(0x100, 4, 0);
#pragma unroll
            for (int ks = 0; ks < NKS; ++ks) {
                if (ks + 2 < NKS) { ka[(ks + 2) % 3][0] = *(const bf16x8*)(Kt + lr * KSTR + 16 * (ks + 2) + 8 * hi); ka[(ks + 2) % 3][1] = *(const bf16x8*)(Kt + (32 + lr) * KSTR + 16 * (ks + 2) + 8 * hi); }
                s0 = MFMA32(ka[ks % 3][0], qf[ks < NQF ? ks : 0], s0); s1 = MFMA32(ka[ks % 3][1], qf[ks < NQF ? ks : 0], s1);
                if (ks + 2 < NKS) __builtin_amdgcn_sched_group_barrier(0x100, 2, 0);
                __builtin_amdgcn_sched_group_barrier(0x008, 2, 0);
            }
        } else {
#pragma unroll
        for (int ks = 0; ks < NKS; ++ks) { const bf16x8 a0 = *(const bf16x8*)(Kt + lr * KSTR + 16 * ks + 8 * hi), a1 = *(const bf16x8*)(Kt + (32 + lr) * KSTR + 16 * ks + 8 * hi);
            bf16x8 qq;
            if (QREG == 1) qq = qf[ks];
            else if (QREG == 2) qq = 16 * ks < DN ? qf[ks < NQF ? ks : 0] : *(const bf16x8*)(qr_row + (16 * ks - DN) + 8 * hi);
            else qq = 16 * ks < DN ? *(const bf16x8*)(qa_row + 16 * ks + 8 * hi) : qf[(16 * ks - DN) / 16 < NQF ? (16 * ks - DN) / 16 : 0];
            s0 = MFMA32(a0, qq, s0); s1 = MFMA32(a1, qq, s1);
            if ((ks & 3) == 3) __builtin_amdgcn_sched_barrier(0); }
        }
        if (t == 0) {
#pragma unroll
            for (int i = 0; i < 16; ++i) { if (i >= 8) s0[i] = -INFINITY; s1[i] = -INFINITY; } }
        float mx = s0[0];
#pragma unroll
        for (int i = 1; i < 16; ++i) mx = fmaxf(mx, s0[i]);
#pragma unroll
        for (int i = 0; i < 16; ++i) mx = fmaxf(mx, s1[i]);
        mx = xhalf_max(mx);
        const float mnew = fmaxf(mrun, mx), alpha = __builtin_amdgcn_exp2f(mrun - mnew);
        const bool resc = __builtin_amdgcn_ballot_w64(mnew != mrun) != 0ull; mrun = mnew;
        float ps = 0.f;
#pragma unroll
        for (int i = 0; i < 16; ++i) { s0[i] = __builtin_amdgcn_exp2f(s0[i] - mnew); s1[i] = __builtin_amdgcn_exp2f(s1[i] - mnew); ps += s0[i] + s1[i]; }
        lrun = lrun * alpha + ps;
        if (resc) {
#pragma unroll
            for (int d = 0; d < 4; ++d)
#pragma unroll
                for (int i = 0; i < 16; ++i) oacc[d][i] *= alpha; }
        bf16x8 pf[4]; pf[0] = packs(s0, 0); pf[1] = packs(s0, 1); pf[2] = packs(s1, 0); pf[3] = packs(s1, 1);
        if (true) {
            bf16x8 va[3];
#pragma unroll
            for (int j = 0; j < 2; ++j) va[j] = ld_perm(Vt + (32 * (j >> 2) + lr) * VSTR + 16 * (j & 3) + 4 * hi);
            __builtin_amdgcn_sched_group_barrier(0x100, 2, 0);
#pragma unroll
            for (int j = 0; j < 16; ++j) {
                if (j + 2 < 16) va[(j + 2) % 3] = ld_perm(Vt + (32 * ((j + 2) >> 2) + lr) * VSTR + 16 * ((j + 2) & 3) + 4 * hi);
                oacc[j >> 2] = MFMA32(va[j % 3], pf[j & 3], oacc[j >> 2]);
                if (j + 2 < 16) __builtin_amdgcn_sched_group_barrier(0x100, 1, 0);
                __builtin_amdgcn_sched_group_barrier(0x008, 1, 0);
            }
        } else {
#pragma unroll
        for (int d = 0; d < 4; ++d)
#pragma unroll
            for (int ks = 0; ks < 4; ++ks) { const bf16x8 a = ld_perm(Vt + (32 * d + lr) * VSTR + 16 * ks + 4 * hi); oacc[d] = MFMA32(a, pf[ks], oacc[d]); if (ks == 3) __builtin_amdgcn_sched_barrier(0); }
        }
    };
    if (SAMPLE) {
        bf16_t* Kt = (bf16_t*)lds; bf16_t* Vt = (bf16_t*)(lds + 64 * KSTR * 2);
        for (int t = 0; t < ntiles; ++t) {
            __syncthreads();
            const int rb = t == 0 ? r0 : r1 + 64 * (t - 1);
#pragma unroll
            for (int i = 0; i < NKC; ++i) { const int e = tid + 512 * i, row = e / CPR, cc = e % CPR; u32x4 w;
                if (t < 33) {
                    if (cc < 32) { const f32x4 a = *(const f32x4*)(cckv + (size_t)(rb + row) * 256 + 8 * cc), b2 = *(const f32x4*)(cckv + (size_t)(rb + row) * 256 + 8 * cc + 4); w.x = pk2(a.x, a.y); w.y = pk2(a.z, a.w); w.z = pk2(b2.x, b2.y); w.w = pk2(b2.z, b2.w); }
                    else { const int q8 = cc - 32; const f32x4 a = *(const f32x4*)(ckr + (size_t)(rb + row) * 64 + 4 * q8), b2 = *(const f32x4*)(ckr + (size_t)(rb + row) * 64 + 32 + 4 * q8); w.x = pk2(a.x, b2.x); w.y = pk2(a.y, b2.y); w.z = pk2(a.z, b2.z); w.w = pk2(a.w, b2.w); }
                } else w = cc < 32 ? *(const u32x4*)(k1 + (size_t)row * ldk1 + 8 * cc) : *(const u32x4*)(k2 + (size_t)row * ldk2 + 8 * (cc - 32));
                *(u32x4*)(Kt + row * KSTR + 8 * cc) = w;
                if (cc < 32 && (cc >> 4) == ps) { const int d0 = 8 * (cc - 16 * ps); const unsigned* wp = (const unsigned*)&w;
#pragma unroll
                    for (int j = 0; j < 4; ++j) { Vt[(d0 + 2 * j) * VSTR + row] = (bf16_t)(wp[j] & 0xffffu); Vt[(d0 + 2 * j + 1) * VSTR + row] = (bf16_t)(wp[j] >> 16); } }
            }
            __syncthreads();
            if (t <= tmax_w) compute(Kt, Vt, t);
        }
    } else {
        gload(0); lstore(0); if (ntiles > 1) gload(1);
        __syncthreads();
        for (int t = 0; t < ntiles; ++t) { const int cur = t & 1;
            if (t + 1 < ntiles) lstore(cur ^ 1);
            if (t + 2 < ntiles) gload(t + 2);
            if (t <= tmax_w) compute((const bf16_t*)(lds + cur * BUFB), (const bf16_t*)(lds + cur * BUFB + 64 * KSTR * 2), t);
            __syncthreads();
        }
    }
    const float lt = xhalf_sum(lrun), inv = 1.f / lt;
    if (store) {
#pragma unroll
        for (int d = 0; d < 4; ++d)
#pragma unroll
            for (int g = 0; g < 4; ++g) { u32x2 w; w.x = pk2(oacc[d][4 * g] * inv, oacc[d][4 * g + 1] * inv); w.y = pk2(oacc[d][4 * g + 2] * inv, oacc[d][4 * g + 3] * inv); *(u32x2*)(orow + 32 * d + 8 * g + 4 * hi) = w; }
    }
    __syncthreads();
}

#ifndef MIX_MASK
#define MIX_MASK 15
#endif
DI void phase_mix(const Prm& p, unsigned char* lds, int tid0, int wid, int lane0) {
    unsigned char* ws = p.ws; const bf16_t* Q = (const bf16_t*)(ws + W_Q); const bf16_t* KN = (const bf16_t*)(ws + W_KN); const bf16_t* VT = (const bf16_t*)(ws + W_VT);
    const bf16_t* HP = (const bf16_t*)(ws + W_HP);
    const bf16_t* QS = (const bf16_t*)(ws + W_QS); bf16_t* OL = (bf16_t*)(ws + W_OL); bf16_t* O = (bf16_t*)(ws + W_XN);
    unsigned* ctr = (unsigned*)(ws + W_CTR); unsigned* sh = (unsigned*)(lds + LDS_BYTES - 64);
    if ((MIX_MASK & 4) && blockIdx.x < 16) gdn_scan_unit(p, lds, 0, blockIdx.x >> 2, blockIdx.x & 3, tid0, wid, lane0);
    const int xcc = (int)(__builtin_amdgcn_s_getreg((3 << 11) | 20) & 7u);
    int qx = 0;
    for (;;) {
        __syncthreads();
        if (tid0 == 0) { int r = -1, q = qx;
            for (; q < 8; ++q) { const unsigned li = atomicAdd(ctr + 64 * ((xcc + q) & 7), 1u); if (li < 90u) { r = ((xcc + q) & 7) * 128 + (int)li; break; } }
            sh[0] = (unsigned)r; sh[1] = (unsigned)q; }
        __syncthreads();
        const int code = (int)sh[0]; qx = (int)sh[1];
        int lane = lane0, tid = tid0; asm volatile("" : "+v"(lane), "+v"(tid)); const int lr = lane & 31;
        if (code < 0) break;
        int it; { const int x = code >> 7, li = code & 127;
            if (li < 8) it = x * 8 + li;
            else if (li < 72) { const int j = li - 8; it = 64 + (j >> 1) * 16 + 2 * x + (j & 1); }
            else if (li < 88) it = 576 + x * 16 + (li - 72);
            else it = 704 + x * 2 + (li - 88); }
        if ((MIX_MASK & 1) && it < 64) {
            const int sb = it >> 1, ps = it & 1, hq = wid >> 1, qrow = sb * 64 + 32 * (wid & 1) + lr;
            attn_unit<256, 2, true>(lds, QS + (size_t)qrow * 1024 + hq * 256, Q + (size_t)(ROW_S + qrow) * 768 + hq * 192 + 128, HP + (size_t)(ROW_S + 64 * sb) * NPJ + C_CKV, NPJ, HP + (size_t)(ROW_S + 64 * sb) * NPJ + C_KR, NPJ,
                           nullptr, 0, 0, 16, 34, 33, OL + (size_t)qrow * 1024 + hq * 256 + 128 * ps, true, tid, lane, p.cache_ckv + (size_t)sb * 2064 * 256, p.cache_kr + (size_t)sb * 2064 * 64, ps);
        } else if ((MIX_MASK & 2) && it >= 64 && it < 576) {
            const int j = it - 64, qb = 31 - (j >> 4), bh = j & 15, b = bh >> 2, h = bh & 3; const int row = b * 8192 + 256 * qb + 32 * wid + lr;
            attn_unit<128, 1, false>(lds, Q + (size_t)row * 768 + h * 192, Q + (size_t)row * 768 + h * 192 + 128, KN + h * 128, 512, HP + C_KR, NPJ, VT + (size_t)(h * 128) * M, M,
                           ROW_META + 16 * b, b * 8192, 4 * qb + 5, 4 * qb + (wid >> 1) + 1, O + (size_t)row * D + 512 + h * 128, true, tid, lane);
        } else if ((MIX_MASK & 4) && it >= 576 && it < 704) {
            const int j = it - 576; gdn_scan_unit(p, lds, 1, j >> 2, j & 3, tid, wid, lane);
        } else if ((MIX_MASK & 8) && it >= 704) {
            const int j = it - 704, b = j >> 2, h = j & 3; const int row = ROW_META + 16 * b + lr;
            attn_unit<128, 1, false>(lds, Q + (size_t)row * 768 + h * 192, Q + (size_t)row * 768 + h * 192 + 128, KN + h * 128, 512, HP + C_KR, NPJ, VT + (size_t)(h * 128) * M, M,
                           ROW_META + 16 * b, b * 8192, 1, wid == 0 ? 0 : -1, O + (size_t)row * D + 512 + h * 128, wid == 0 && lane < 16 || (wid == 0 && lane >= 32 && lane < 48), tid, lane);
        }
    }
}

DI void phase_gdn_gate(const Prm& p, int gw, int ngw, int lane) {
    bf16_t* O = (bf16_t*)(p.ws + W_XN); const bf16_t* HP = (const bf16_t*)(p.ws + W_HP);
    for (int r = gw; r < ROW_PAD; r += ngw) {
        u32x4* q = (u32x4*)(O + (size_t)r * D) + lane; const u32x4 u = *q; const u32x4 z = *((const u32x4*)(HP + (size_t)r * NPJ + C_Z) + lane);
        float v[8] = {bflo(u.x), bfhi(u.x), bflo(u.y), bfhi(u.y), bflo(u.z), bfhi(u.z), bflo(u.w), bfhi(u.w)};
        float zz[8] = {bflo(z.x), bfhi(z.x), bflo(z.y), bfhi(z.y), bflo(z.z), bfhi(z.z), bflo(z.w), bfhi(z.w)};
        float ss = 0.f;
#pragma unroll
        for (int j = 0; j < 8; ++j) ss += v[j] * v[j];
        ss = row16_sum(ss);
        const float rstd = rsqrtf(ss * (1.f / 128.f) + 1e-6f); const int c0 = (8 * lane) & 127;
#pragma unroll
        for (int j = 0; j < 8; ++j) v[j] = v[j] * rstd * p.gdn_norm[c0 + j] * siluf(zz[j]);
        u32x4 w; w.x = pk2(v[0], v[1]); w.y = pk2(v[2], v[3]); w.z = pk2(v[4], v[5]); w.w = pk2(v[6], v[7]); *q = w;
    }
}

namespace pg8 {
#define PG8_LAS __attribute__((address_space(3)))
typedef unsigned short bf16_t;
typedef short bf16x8 __attribute__((ext_vector_type(8)));
typedef float f32x4 __attribute__((ext_vector_type(4)));
typedef unsigned u32x4 __attribute__((ext_vector_type(4)));
constexpr int BM = 256, BK = 64, HALF = 128, HTB = HALF * BK * 2  , STAGE_BYTES = 8 * HTB, NXCD = 8, WGM = 8;

__host__ __device__ __forceinline__ int lds_byte(int r, int c) { const int st = (r >> 4) * 2 + (c >> 5), rr = r & 15, cc = c & 31, ob = rr * 64 + cc * 2; return st * 1024 + (ob ^ (((ob >> 9) & 1) << 5)); }
__host__ __device__ __forceinline__ void stage_rc(int b, int& R, int& C) { const int st = b / 1024, sb = b % 1024, swz = sb ^ (((sb >> 9) & 1) << 5); R = (st >> 1) * 16 + swz / 64; C = (st & 1) * 32 + (swz % 64) / 2; }
__host__ __device__ __forceinline__ int perm32(int rho) { const int n = rho >> 4, i = rho & 15; return 8 * (i >> 2) + 4 * n + (i & 3); }

struct Unit { int pm, pn; size_t koff; int aux; };
struct Gemm { const bf16_t* A; const bf16_t* Bt; int M, N, K, lda, ldb; };

struct StaticOrder {
    int nM, nN, nwg, G, c;
    __host__ __device__ void init(int M, int N, int G_, int c_) { nM = M / BM; nN = N / BM; nwg = nM * nN; G = G_; c = c_; }
    __host__ __device__ bool mapL(long L, Unit& u) const {
        if (L >= nwg) return false;
        int wgid = (int)L; { const int q = nwg / NXCD, r = nwg % NXCD, xcd = wgid % NXCD, off = wgid / NXCD; wgid = (xcd < r ? xcd * (q + 1) : r * (q + 1) + (xcd - r) * q) + off; }
        const int nig = WGM * nN, gid = wgid / nig, fm = gid * WGM, gsz = (nM - fm) < WGM ? (nM - fm) : WGM;
        u.pm = fm + ((wgid % nig) % gsz); u.pn = (wgid % nig) / gsz; u.koff = 0; u.aux = 0; return true;
    }
    __host__ __device__ bool next(int i, Unit& u) const { return mapL((long)i * G + c, u); }
    __device__ __forceinline__ void a_ready(const Unit&) const {}
    __device__ __forceinline__ void done(const Unit&) const {}
};
struct HeadOrder { StaticOrder s; int cnt;
    __device__ bool next(int i, Unit& u) const { return i < cnt && s.next(i, u); }
    __device__ __forceinline__ void a_ready(const Unit&) const {}
    __device__ __forceinline__ void done(const Unit&) const {} };
struct TailOrder { StaticOrder s; int base, KS, total; size_t kbytes;
    __device__ bool next(int i, Unit& u) const { const int q = i * s.G + s.c; if (q >= total) return false; if (!s.mapL((long)base * s.G + q / KS, u)) return false; u.koff = (size_t)(q % KS) * kbytes; u.aux = q; return true; }
    __device__ __forceinline__ void a_ready(const Unit&) const {}
    __device__ __forceinline__ void done(const Unit&) const {} };

template <class Epi, class Sched, bool ALIGN_EPI = false, bool SP2 = false>
__device__ __forceinline__ void gemm_phase(PG8_LAS unsigned char* lds, const Gemm g, const Sched& S, const Epi& E) {
    int tid = threadIdx.x; asm volatile("" : "+v"(tid));
    const int wid = __builtin_amdgcn_readfirstlane(tid >> 6), lane = tid & 63, wr = wid >> 2, wc = wid & 3, fr = lane & 15, fq = lane >> 4;
    const int K = g.K, nt = K / BK;
    unsigned voffA[2], voffB[2];
#pragma unroll
    for (int i = 0; i < 2; ++i) { int R, C; stage_rc(tid * 16 + i * 8192, R, C); const int Rb = Epi::PERM ? ((R & ~31) + perm32(R & 31)) : R;
        voffA[i] = (unsigned)(R * g.lda + C) * 2u; voffB[i] = (unsigned)(Rb * g.ldb + C) * 2u; }
    const size_t kstep = (size_t)(BK * 2);
    const size_t hstepA = (size_t)HALF * g.lda * 2, hstepB = (size_t)HALF * g.ldb * 2;
    const size_t tstepA = 2 * hstepA, tstepB = 2 * hstepB;
    const unsigned ldsw = (unsigned)wid * 1024u;
    const int aoff = lds_byte(wr * 64 + fr, fq * 8), boff = lds_byte(wc * 32 + fr, fq * 8);
#define PG8_SA(b, h) (((b) * 2 + (h)) * HTB)
#define PG8_SB(b, h) ((4 + (b) * 2 + (h)) * HTB)
#define PG8_STAGE(bufoff, gbase, voff) do { _Pragma("unroll") for (int _i = 0; _i < 2; ++_i) \
        __builtin_amdgcn_global_load_lds((const unsigned*)((const char*)(gbase) + (voff)[_i]), (PG8_LAS unsigned*)(lds + (bufoff) + ldsw + _i * 8192), 16, 0, 0); } while (0)
#define PG8_LDA(dst, b, h) do { _Pragma("unroll") for (int m = 0; m < 4; ++m) _Pragma("unroll") for (int k = 0; k < 2; ++k) dst[m][k] = *(const PG8_LAS bf16x8*)(lds + PG8_SA(b, h) + aoff + m * 2048 + k * 1024); } while (0)
#define PG8_LDB(dst, b, h) do { _Pragma("unroll") for (int n = 0; n < 2; ++n) _Pragma("unroll") for (int k = 0; k < 2; ++k) dst[n][k] = *(const PG8_LAS bf16x8*)(lds + PG8_SB(b, h) + boff + n * 2048 + k * 1024); } while (0)
#define PG8_MMA(ai, bj, At, Bt) do { __builtin_amdgcn_s_setprio(1); _Pragma("unroll") for (int m = 0; m < 4; ++m) _Pragma("unroll") for (int n = 0; n < 2; ++n) _Pragma("unroll") for (int k = 0; k < 2; ++k) \
        acc[ai][bj][m][n] = __builtin_amdgcn_mfma_f32_16x16x32_bf16(Bt[n][k], At[m][k], acc[ai][bj][m][n], 0, 0, 0); __builtin_amdgcn_s_setprio(0); } while (0)
#define PG8_WAIT_V(n) asm volatile("s_waitcnt vmcnt(" #n ")" ::: "memory")
#define PG8_WAIT_L(n) asm volatile("s_waitcnt lgkmcnt(" #n ")" ::: "memory")
#define PG8_BAR __builtin_amdgcn_s_barrier()
#define PG8_SCHED __builtin_amdgcn_sched_barrier(0)
    Unit cur, nxt; int ui = 0;
    if (!S.next(0, cur)) return;
    f32x4 acc[2][2][4][2];
#pragma unroll
    for (int a = 0; a < 2; ++a)
#pragma unroll
        for (int b = 0; b < 2; ++b)
#pragma unroll
            for (int m = 0; m < 4; ++m)
#pragma unroll
                for (int n = 0; n < 2; ++n) acc[a][b][m][n] = (f32x4){0.f, 0.f, 0.f, 0.f};
    bf16x8 At[4][2], B0[2][2], B1[2][2];
    const char* cA = (const char*)g.A + (size_t)cur.pm * tstepA + cur.koff; const char* cB = (const char*)g.Bt + (size_t)cur.pn * tstepB + cur.koff;
    S.a_ready(cur);
    if constexpr (SP2) {
        PG8_STAGE(PG8_SB(0, 0), cB, voffB); PG8_STAGE(PG8_SB(0, 1), cB + hstepB, voffB); PG8_STAGE(PG8_SA(0, 0), cA, voffA); PG8_STAGE(PG8_SA(0, 1), cA + hstepA, voffA);
        if (wr == 1) PG8_BAR;
        PG8_WAIT_V(2); PG8_BAR;
        PG8_STAGE(PG8_SB(1, 0), cB + kstep, voffB); PG8_STAGE(PG8_SA(1, 0), cA + kstep, voffA); PG8_STAGE(PG8_SB(1, 1), cB + hstepB + kstep, voffB);
        PG8_WAIT_V(6); PG8_BAR;
    } else {
        PG8_STAGE(PG8_SB(0, 0), cB, voffB); PG8_STAGE(PG8_SA(0, 0), cA, voffA); PG8_STAGE(PG8_SB(0, 1), cB + hstepB, voffB); PG8_STAGE(PG8_SA(0, 1), cA + hstepA, voffA);
        if (wr == 1) PG8_BAR;
        PG8_WAIT_V(4); PG8_BAR;
        PG8_STAGE(PG8_SB(1, 0), cB + kstep, voffB); PG8_STAGE(PG8_SA(1, 0), cA + kstep, voffA); PG8_STAGE(PG8_SB(1, 1), cB + hstepB + kstep, voffB);
        PG8_WAIT_V(6); PG8_BAR;
    }
    for (;;) {
        const bool has_next = S.next(ui + 1, nxt);
        const char* nA = has_next ? (const char*)g.A + (size_t)nxt.pm * tstepA + nxt.koff : cA; const char* nB = has_next ? (const char*)g.Bt + (size_t)nxt.pn * tstepB + nxt.koff : cB;
        for (int t = 0; t < nt; t += 2) {
            const bool last = (t == nt - 2);
            const char* a1 = cA + (size_t)(t + 1) * kstep;
            const char* a2 = last ? nA : cA + (size_t)(t + 2) * kstep; const char* b2 = last ? nB : cB + (size_t)(t + 2) * kstep;
            const char* a3 = a2 + kstep; const char* b3 = b2 + kstep;
            if (last && has_next) S.a_ready(nxt);
            if constexpr (SP2) {
            PG8_LDB(B0, 0, 0); PG8_LDB(B1, 0, 1); PG8_SCHED; PG8_LDA(At, 0, 0); PG8_STAGE(PG8_SA(1, 1), a1 + hstepA, voffA);
            PG8_WAIT_V(8); PG8_WAIT_L(0); PG8_BAR; PG8_MMA(0, 0, At, B0); PG8_MMA(0, 1, At, B1); PG8_BAR; PG8_SCHED;
            PG8_LDA(At, 0, 1); PG8_STAGE(PG8_SB(0, 0), b2, voffB); PG8_STAGE(PG8_SB(0, 1), b2 + hstepB, voffB); PG8_STAGE(PG8_SA(0, 0), a2, voffA);
            PG8_WAIT_V(8); PG8_WAIT_L(0); PG8_BAR; PG8_MMA(1, 0, At, B0); PG8_MMA(1, 1, At, B1); PG8_BAR; PG8_SCHED;
            PG8_LDB(B0, 1, 0); PG8_LDB(B1, 1, 1); PG8_SCHED; PG8_LDA(At, 1, 0); PG8_STAGE(PG8_SA(0, 1), a2 + hstepA, voffA);
            PG8_WAIT_V(8); PG8_WAIT_L(0); PG8_BAR; PG8_MMA(0, 0, At, B0); PG8_MMA(0, 1, At, B1); PG8_BAR; PG8_SCHED;
            PG8_LDA(At, 1, 1); PG8_STAGE(PG8_SB(1, 0), b3, voffB); PG8_STAGE(PG8_SB(1, 1), b3 + hstepB, voffB); PG8_STAGE(PG8_SA(1, 0), a3, voffA);
            PG8_WAIT_V(8); PG8_WAIT_L(0); PG8_BAR; PG8_MMA(1, 0, At, B0); PG8_MMA(1, 1, At, B1); PG8_BAR; PG8_SCHED;
            } else {
            PG8_LDB(B0, 0, 0); PG8_SCHED; PG8_LDA(At, 0, 0); PG8_STAGE(PG8_SA(1, 1), a1 + hstepA, voffA);
            PG8_WAIT_L(8); PG8_BAR; PG8_WAIT_L(0); PG8_MMA(0, 0, At, B0); PG8_BAR; PG8_SCHED;
            PG8_LDB(B1, 0, 1); PG8_STAGE(PG8_SB(0, 0), b2, voffB);
            PG8_BAR; PG8_WAIT_L(0); PG8_MMA(0, 1, At, B1); PG8_BAR;
            PG8_LDA(At, 0, 1); PG8_STAGE(PG8_SA(0, 0), a2, voffA);
            PG8_BAR; PG8_WAIT_L(0); PG8_MMA(1, 0, At, B0); PG8_BAR; PG8_SCHED;
            PG8_STAGE(PG8_SB(0, 1), b2 + hstepB, voffB);
            PG8_WAIT_V(6); PG8_BAR; PG8_MMA(1, 1, At, B1); PG8_BAR;
            PG8_LDB(B0, 1, 0); PG8_SCHED; PG8_LDA(At, 1, 0); PG8_STAGE(PG8_SA(0, 1), a2 + hstepA, voffA);
            PG8_WAIT_L(8); PG8_BAR; PG8_WAIT_L(0); PG8_MMA(0, 0, At, B0); PG8_BAR; PG8_SCHED;
            PG8_LDB(B1, 1, 1); PG8_STAGE(PG8_SB(1, 0), b3, voffB);
            PG8_BAR; PG8_WAIT_L(0); PG8_MMA(0, 1, At, B1); PG8_BAR;
            PG8_LDA(At, 1, 1); PG8_STAGE(PG8_SA(1, 0), a3, voffA);
            PG8_BAR; PG8_WAIT_L(0); PG8_MMA(1, 0, At, B0); PG8_BAR; PG8_SCHED;
            PG8_STAGE(PG8_SB(1, 1), b3 + hstepB, voffB);
            PG8_WAIT_V(6); PG8_BAR; PG8_MMA(1, 1, At, B1); PG8_BAR;
            }
        }
        if constexpr (ALIGN_EPI) { if (wr == 0) PG8_BAR; }
        if constexpr (!Epi::AFTER_DRAIN) { E(acc, cur, wr, wc, fr, fq); S.done(cur); }
        if (!has_next) break;
#pragma unroll
        for (int a = 0; a < 2; ++a)
#pragma unroll
            for (int b = 0; b < 2; ++b)
#pragma unroll
                for (int m = 0; m < 4; ++m)
#pragma unroll
                    for (int n = 0; n < 2; ++n) acc[a][b][m][n] = (f32x4){0.f, 0.f, 0.f, 0.f};
        cur = nxt; cA = nA; cB = nB; ++ui;
        if constexpr (ALIGN_EPI) { if (wr == 1) PG8_BAR; }
    }
    PG8_WAIT_V(0);
    if constexpr (!ALIGN_EPI) { if (wr == 0) PG8_BAR; }
    PG8_BAR;
    if constexpr (Epi::AFTER_DRAIN) { E.fused(acc, cur, wr, wc, fr, fq, lds, wid, lane); S.done(cur); }
#undef PG8_SA
#undef PG8_SB
#undef PG8_STAGE
#undef PG8_LDA
#undef PG8_LDB
#undef PG8_MMA
#undef PG8_WAIT_V
#undef PG8_WAIT_L
#undef PG8_BAR
#undef PG8_SCHED
}
}

struct PEpiGU {
    static constexpr bool PERM = true, AFTER_DRAIN = false; bf16_t* H; const float* rss;
    DI void operator()(const f32x4 (&acc)[2][2][4][2], const pg8::Unit& u, int wr, int wc, int fr, int fq) const {
#pragma unroll
        for (int ai = 0; ai < 2; ++ai)
#pragma unroll
            for (int m = 0; m < 4; ++m) { const int r = u.pm * 256 + ai * 128 + wr * 64 + m * 16 + fr; bf16_t* rowp = H + (size_t)r * DFF + u.pn * 128 + wc * 32 + 8 * fq; float v[8]; const float sr = rss ? rss_rstd(rss, r) : 1.f;
#pragma unroll
                for (int n = 0; n < 2; ++n)
#pragma unroll
                    for (int e = 0; e < 4; ++e) v[4 * n + e] = siluf(acc[ai][0][m][n][e] * sr) * (acc[ai][1][m][n][e] * sr);
                u32x4 w; w.x = pk2(v[0], v[1]); w.y = pk2(v[2], v[3]); w.z = pk2(v[4], v[5]); w.w = pk2(v[6], v[7]); *(u32x4*)rowp = w; }
    }
};
struct PEpiRes {
    static constexpr bool PERM = false, AFTER_DRAIN = false; Prm p; float alpha; int from_inputs; bf16_t* xn; const float* gnext; float* rss;
    DI void operator()(const f32x4 (&acc)[2][2][4][2], const pg8::Unit& u, int wr, int wc, int fr, int fq) const {
        const int col0 = u.pn * 256 + wc * 32 + 4 * fq;
#pragma unroll
        for (int ai = 0; ai < 2; ++ai)
#pragma unroll
            for (int m = 0; m < 4; ++m) { const int r = u.pm * 256 + ai * 128 + wr * 64 + m * 16 + fr; float* rowp = xrow(p, r) + col0; const float* srcp = from_inputs ? x0row(p, r) : xrow(p, r); float ss = 0.f;
#pragma unroll
                for (int bj = 0; bj < 2; ++bj)
#pragma unroll
                    for (int n = 0; n < 2; ++n) { const int co = bj * 128 + n * 16; f32x4 x = srcp ? *(const f32x4*)(srcp + col0 + co) : (f32x4){0.f, 0.f, 0.f, 0.f}; x = x + acc[ai][bj][m][n] * alpha; *(f32x4*)(rowp + co) = x;
                        if (xn) { const f32x4 g = *(const f32x4*)(gnext + col0 + co); ss += x.x * x.x + x.y * x.y + x.z * x.z + x.w * x.w; u32x2 w; w.x = pk2(x.x * g.x, x.y * g.y); w.y = pk2(x.z * g.z, x.w * g.w); *(u32x2*)(xn + (size_t)r * D + col0 + co) = w; } }
                if (xn) { ss += __shfl_xor(ss, 16); ss += __shfl_xor(ss, 32); if (fq == 0) rss[(size_t)r * 16 + u.pn * 4 + wc] = ss; } }
    }
};
struct PEpiBf {
    static constexpr bool PERM = true, AFTER_DRAIN = false; bf16_t* O; int ldc; float sc; const float* rss;
    DI void operator()(const f32x4 (&acc)[2][2][4][2], const pg8::Unit& u, int wr, int wc, int fr, int fq) const {
#pragma unroll
        for (int ai = 0; ai < 2; ++ai)
#pragma unroll
            for (int m = 0; m < 4; ++m) { const int r = u.pm * 256 + ai * 128 + wr * 64 + m * 16 + fr; bf16_t* rowp = O + (size_t)r * ldc + u.pn * 256 + wc * 32 + 8 * fq; const float sr = rss ? sc * rss_rstd(rss, r) : sc;
#pragma unroll
                for (int bj = 0; bj < 2; ++bj) { const f32x4 a = acc[ai][bj][m][0] * sr, b = acc[ai][bj][m][1] * sr; u32x4 w; w.x = pk2(a[0], a[1]); w.y = pk2(a[2], a[3]); w.z = pk2(b[0], b[1]); w.w = pk2(b[2], b[3]); *(u32x4*)(rowp + bj * 128) = w; } }
    }
};
struct PEpiQ {
    static constexpr bool PERM = true, AFTER_DRAIN = false; bf16_t* Q; const float* tbl;
    DI void operator()(const f32x4 (&acc)[2][2][4][2], const pg8::Unit& u, int wr, int wc, int fr, int fq) const {
#pragma unroll
        for (int ai = 0; ai < 2; ++ai)
#pragma unroll
            for (int m = 0; m < 4; ++m) { const int r = u.pm * 256 + ai * 128 + wr * 64 + m * 16 + fr; const float* tb = tbl + (size_t)rowpos(r) * 64;
#pragma unroll
                for (int bj = 0; bj < 2; ++bj) { const int c = u.pn * 256 + bj * 128 + wc * 32 + 8 * fq, j = c % 192; const f32x4 a = acc[ai][bj][m][0], b = acc[ai][bj][m][1];
                    float v[8] = {a[0], a[1], a[2], a[3], b[0], b[1], b[2], b[3]};
                    if (j >= 128) { const int i0 = (j - 128) >> 1;
#pragma unroll
                        for (int q = 0; q < 4; ++q) { const float cs = tb[i0 + q], sn = tb[32 + i0 + q], x1 = v[2 * q], x2 = v[2 * q + 1]; v[2 * q] = x1 * cs - x2 * sn; v[2 * q + 1] = x2 * cs + x1 * sn; } }
                    u32x4 w; w.x = pk2(v[0] * QSCALE, v[1] * QSCALE); w.y = pk2(v[2] * QSCALE, v[3] * QSCALE); w.z = pk2(v[4] * QSCALE, v[5] * QSCALE); w.w = pk2(v[6] * QSCALE, v[7] * QSCALE);
                    *(u32x4*)(Q + (size_t)r * 768 + c) = w; } }
    }
};
struct PEpiPart {
    static constexpr bool PERM = false, AFTER_DRAIN = false; float* part;
    DI void operator()(const f32x4 (&acc)[2][2][4][2], const pg8::Unit& u, int wr, int wc, int fr, int fq) const {
        float* tp = part + (size_t)u.aux * 65536 + wc * 32 + 4 * fq;
#pragma unroll
        for (int ai = 0; ai < 2; ++ai)
#pragma unroll
            for (int m = 0; m < 4; ++m) { float* rowp = tp + (size_t)(ai * 128 + wr * 64 + m * 16 + fr) * 256;
#pragma unroll
                for (int bj = 0; bj < 2; ++bj)
#pragma unroll
                    for (int n = 0; n < 2; ++n) *(f32x4*)(rowp + bj * 128 + n * 16) = acc[ai][bj][m][n]; }
    }
};
constexpr int TAIL_KS = 2;
template <class Epi> DI void pgemm_head(unsigned char* lds, const bf16_t* A, int lda, const bf16_t* Bt, int ldb, int Mg, int Ng, int K, const Epi& E) {
    pg8::Gemm g{A, Bt, Mg, Ng, K, lda, ldb}; pg8::HeadOrder S; S.s.init(Mg, Ng, (int)gridDim.x, (int)blockIdx.x); S.cnt = S.s.nwg / (int)gridDim.x;
    pg8::gemm_phase<Epi, pg8::HeadOrder, true, true>((PG8_LAS unsigned char*)lds, g, S, E);
    __syncthreads();
}
DI void pgemm_tail(unsigned char* lds, const bf16_t* A, int lda, const bf16_t* Bt, int ldb, int Mg, int Ng, int K, float* part) {
    pg8::TailOrder S; S.s.init(Mg, Ng, (int)gridDim.x, (int)blockIdx.x); S.base = S.s.nwg / (int)gridDim.x; S.KS = TAIL_KS; S.total = (S.s.nwg % (int)gridDim.x) * TAIL_KS; S.kbytes = (size_t)(K / TAIL_KS) * 2;
    pg8::Gemm g{A, Bt, Mg, Ng, K / TAIL_KS, lda, ldb};
    pg8::gemm_phase<PEpiPart, pg8::TailOrder, true, true>((PG8_LAS unsigned char*)lds, g, S, PEpiPart{part});
    __syncthreads();
}
DI void tail_combine(const Prm& p, int Mg, int Ng, const float* part, float alpha, int from_inputs, bf16_t* xn, const float* gnext, float* rss, int gw, int ngw, int lane) {
    pg8::StaticOrder S; S.init(Mg, Ng, (int)gridDim.x, 0); const int base = S.nwg / (int)gridDim.x, ntail = S.nwg % (int)gridDim.x;
    for (int it = gw; it < ntail * 256; it += ngw) { const int j = it >> 8, rr = it & 255; pg8::Unit u; S.mapL((long)base * S.G + j, u);
        const int r = u.pm * 256 + rr, col = u.pn * 256 + 4 * lane; const float* srcp = from_inputs ? x0row(p, r) : xrow(p, r);
        f32x4 x = srcp ? *(const f32x4*)(srcp + col) : (f32x4){0.f, 0.f, 0.f, 0.f};
#pragma unroll
        for (int kz = 0; kz < TAIL_KS; ++kz) x = x + *(const f32x4*)(part + (size_t)(j * TAIL_KS + kz) * 65536 + rr * 256 + 4 * lane) * alpha;
        *(f32x4*)(xrow(p, r) + col) = x;
        if (xn) { const f32x4 g = *(const f32x4*)(gnext + col); u32x2 w; w.x = pk2(x.x * g.x, x.y * g.y); w.y = pk2(x.z * g.z, x.w * g.w); *(u32x2*)(xn + (size_t)r * D + col) = w;
            const float ss = wave_sum(x.x * x.x + x.y * x.y + x.z * x.z + x.w * x.w); if (lane < 4) rss[(size_t)r * 16 + u.pn * 4 + lane] = lane == 0 ? ss : 0.f; } }
}
DI void late_panels(int Mg, int Ng, unsigned (&mask)[5], unsigned char* lds, int tid) {
    unsigned* lm = (unsigned*)(lds + 1024);
    pg8::StaticOrder S; S.init(Mg, Ng, (int)gridDim.x, 0); const int base = S.nwg / (int)gridDim.x, ntail = S.nwg % (int)gridDim.x;
    __syncthreads();
    if (tid < 5) lm[tid] = 0u;
    __syncthreads();
    for (int j = tid; j < ntail; j += 512) { pg8::Unit u; S.mapL((long)base * S.G + j, u); atomicOr(lm + (u.pm >> 5), 1u << (u.pm & 31)); }
    __syncthreads();
#pragma unroll
    for (int i = 0; i < 5; ++i) mask[i] = lm[i];
    __syncthreads();
}
template <class Epi> DI void pgemm(unsigned char* lds, const bf16_t* A, int lda, const bf16_t* Bt, int ldb, int Mg, int Ng, int K, const Epi& E) {
    pg8::Gemm g{A, Bt, Mg, Ng, K, lda, ldb}; pg8::StaticOrder S; S.init(Mg, Ng, (int)gridDim.x, (int)blockIdx.x);
    pg8::gemm_phase<Epi, pg8::StaticOrder, true, true>((PG8_LAS unsigned char*)lds, g, S, E);
    __syncthreads();
}

#define LAS __attribute__((address_space(3)))
#define XB_TMO      128
#define XB_XCNT(j)  (256  + 64 * (j))
#define XB_XSUB(j)  (1280 + 64 * (j))
#define XB_XGEN(j)  (2304 + 64 * (j))
#define XB_TOP      3328
#define XB_TOPGEN   3392
#define XCD_BAR_WORDS 3456
#define XB_SPIN_CAP (1u << 22)

__device__ __forceinline__ unsigned xb_ld(unsigned* p)              { return __hip_atomic_load(p, __ATOMIC_RELAXED, __HIP_MEMORY_SCOPE_AGENT); }
__device__ __forceinline__ unsigned xb_add(unsigned* p, unsigned v) { return __hip_atomic_fetch_add(p, v, __ATOMIC_RELAXED, __HIP_MEMORY_SCOPE_AGENT); }
__device__ __forceinline__ unsigned xb_xcc_id() { return (unsigned)__builtin_amdgcn_s_getreg((3 << 11) | 20) & 0xFu; }
#define XB_SPIN(cond, bar) do { unsigned _sp = 0; while (cond) { __builtin_amdgcn_s_sleep(1); \
    if ((++_sp & 255u) == 0u) { if (xb_ld(&(bar)[XB_TMO])) break; if (_sp > XB_SPIN_CAP) { atomicAdd(&(bar)[XB_TMO], 1u); break; } } } } while (0)

struct XcdBarrier {
    unsigned* bar; unsigned x;
    volatile LAS unsigned* st;
};

__device__ __forceinline__ XcdBarrier xcd_barrier_post(unsigned* bar, volatile LAS unsigned* st) {
    XcdBarrier b; b.bar = bar; b.x = xb_xcc_id(); b.st = st;
    if (threadIdx.x == 0) (void)xb_add(&bar[XB_XCNT(b.x)], 1u);
    return b;
}
__device__ __forceinline__ void xcd_barrier_complete(unsigned* bar, unsigned x, unsigned& nloc, unsigned& nx) {
    const unsigned G = gridDim.x * gridDim.y * gridDim.z;
    unsigned sum, cnt, mine, sp = 0u;
    for (;;) {
        sum = 0u; cnt = 0u; mine = 0u;
#pragma unroll
        for (unsigned j = 0; j < 16; ++j) { const unsigned c = xb_ld(&bar[XB_XCNT(j)]); sum += c; cnt += (c > 0u) ? 1u : 0u; mine = (j == x) ? c : mine; }
        if (sum == G) break;
        __builtin_amdgcn_s_sleep(1);
        if ((++sp & 255u) == 0u) { if (xb_ld(&bar[XB_TMO])) break; if (sp > XB_SPIN_CAP) { atomicAdd(&bar[XB_TMO], 1u); break; } }
    }
    nloc = mine > 0u ? mine : 1u; nx = cnt > 0u ? cnt : 1u;
}

__device__ __forceinline__ void xcd_barrier(const XcdBarrier& b) {
    asm volatile("s_waitcnt vmcnt(0)" ::: "memory");
    __syncthreads();
    if (threadIdx.x == 0) {
        unsigned* bar = b.bar;
        __builtin_amdgcn_s_waitcnt(0);
        unsigned nloc = b.st[0], nx = b.st[1];
        if (nloc == 0u) { xcd_barrier_complete(bar, b.x, nloc, nx); b.st[0] = nloc; b.st[1] = nx; }
        const unsigned old = xb_add(&bar[XB_XSUB(b.x)], 1u);
        const unsigned gen = old / nloc;
        if (old + 1u == (gen + 1u) * nloc) {
            __builtin_amdgcn_fence(__ATOMIC_RELEASE, "agent");
            asm volatile("s_waitcnt vmcnt(0)" ::: "memory");
            const unsigned og = xb_add(&bar[XB_TOP], 1u);
            const unsigned tg = og / nx;
            if (og + 1u == (tg + 1u) * nx) xb_add(&bar[XB_TOPGEN], 1u);
            else XB_SPIN(xb_ld(&bar[XB_TOPGEN]) == tg, bar);
            __builtin_amdgcn_fence(__ATOMIC_ACQUIRE, "agent");
            xb_add(&bar[XB_XGEN(b.x)], 1u);
            asm volatile("s_waitcnt vmcnt(0)" ::: "memory");
        } else {
            XB_SPIN(xb_ld(&bar[XB_XGEN(b.x)]) == gen, bar);
            __builtin_amdgcn_fence(__ATOMIC_ACQUIRE, "agent");
            asm volatile("s_waitcnt vmcnt(0)" ::: "memory");
        }
    }
    __syncthreads();
}

constexpr int NPHASE = 17;
DI void run_phase(const Prm& p, int ph, unsigned char* lds, int tid, int wid, int lane) {
    unsigned char* ws = p.ws; const int gw = blockIdx.x * 8 + wid, ngw = gridDim.x * 8;
    bf16_t* XN = (bf16_t*)(ws + W_XN); bf16_t* HP = (bf16_t*)(ws + W_HP);
    switch (ph) {
    case 0: phase_prep(p, tid, lane, wid); break;
    case 1: pgemm(lds, XN, D, (const bf16_t*)(ws + W_WGU1), D, M, 5632, D, PEpiGU{HP, nullptr});
        {
            const int G = (int)gridDim.x, rem = ((M / 256) * (5632 / 256)) % G, c = (int)blockIdx.x;
            if (rem == 0) cvt_ffn(p, 0, c * 512 + tid, G * 512, 2); else if (c >= rem) cvt_ffn(p, 0, (c - rem) * 512 + tid, (G - rem) * 512, 2);
        }
        break;
    case 2: pgemm_head(lds, HP, DFF, (const bf16_t*)(ws + W_WD1), DFF, M, D, DFF, PEpiRes{p, 0.5f, 1, XN, p.mix_norm, (float*)(ws + W_RSS)}); break;
    case 19: pgemm_tail(lds, HP, DFF, (const bf16_t*)(ws + W_WD1), DFF, M, D, DFF, (float*)(ws + W_Q));
        {
            const int G = (int)gridDim.x, nt_ = (((M / 256) * (D / 256)) % G) * TAIL_KS, c = (int)blockIdx.x;
            if (nt_ == 0 || nt_ >= G) prep_late(p, c * 512 + tid, G * 512); else if (c >= nt_) prep_late(p, (c - nt_) * 512 + tid, (G - nt_) * 512);
        }
        break;
    case 20: tail_combine(p, M, D, (const float*)(ws + W_Q), 0.5f, 1, XN, p.mix_norm, (float*)(ws + W_RSS), gw, ngw, lane); break;
    case 4: pgemm(lds, XN, D, (const bf16_t*)(ws + W_WIN), D, M, NPJ, D, PEpiBf{HP, NPJ, 1.f, (const float*)(ws + W_RSS)}); break;
    case 5: phase_post(p, gw, ngw, lane); break;
    case 6: pgemm(lds, HP + C_CQ, NPJ, (const bf16_t*)(ws + W_WUQ), 384, M, 768, 384, PEpiBf{(bf16_t*)(ws + W_Q), 768, QSCALE, nullptr}); break;
    case 15: pgemm(lds, HP + C_CKV, NPJ, (const bf16_t*)(ws + W_WKN), 256, M, 512, 256, PEpiBf{(bf16_t*)(ws + W_KN), 512, 1.f, nullptr}); break;
    case 16: pgemm(lds, (const bf16_t*)(ws + W_WVT), 256, HP + C_CKV, NPJ, 512, M, 256, PEpiBf{(bf16_t*)(ws + W_VT), M, 1.f, nullptr}); break;
    case 17: phase_gdn_pre(p, lds, tid, wid, lane); break;
    case 7:
        {
            bf16_t* Qb = (bf16_t*)(ws + W_Q); const float* tbl = (const float*)(ws + W_TBL);
            for (int it = blockIdx.x * 512 + tid; it < M * 32; it += gridDim.x * 512) { const int r = it >> 5, h = (it >> 3) & 3, q8 = it & 7; u32x4* qp = (u32x4*)(Qb + (size_t)r * 768 + h * 192 + 128 + 8 * q8); u32x4 u = *qp; const float* tb = tbl + (size_t)rowpos(r) * 64 + 4 * q8;
                unsigned* uu = (unsigned*)&u;
#pragma unroll
                for (int q = 0; q < 4; ++q) { const float x1 = bflo(uu[q]), x2 = bfhi(uu[q]), cs = tb[q], sn = tb[32 + q]; uu[q] = pk2(x1 * cs - x2 * sn, x2 * cs + x1 * sn); }
                *qp = u; }
        }
        for (int h = 0; h < 4; ++h)
            gemm_simple((const bf16_t*)(ws + W_Q) + (size_t)ROW_S * 768 + h * 192, 768, (const bf16_t*)(ws + W_WUKV) + h * 256, 1024, 2048, 256, 128, EpiBf{(bf16_t*)(ws + W_QS) + h * 256, 1024}, gw, ngw, lane);
        break;
    case 8: phase_mix(p, lds, tid, wid, lane); break;
    case 9:
        phase_gdn_gate(p, gw, ngw, lane);
        for (int h = 0; h < 4; ++h)
            gemm_simple((const bf16_t*)(ws + W_OL) + h * 256, 1024, (const bf16_t*)(ws + W_WVT) + (size_t)h * 128 * 256, 256, 2048, 128, 256, EpiBf{XN + (size_t)ROW_S * D + 512 + h * 128, D}, gw, ngw, lane);
        break;
    case 10: pgemm(lds, XN, D, (const bf16_t*)(ws + W_WO), D, M, D, D, PEpiRes{p, 1.0f, 0, (bf16_t*)(ws + W_Q), p.ffn2_norm, (float*)(ws + W_RSS) + (size_t)M * 16}); break;
    case 12: pgemm(lds, (const bf16_t*)(ws + W_Q), D, (const bf16_t*)(ws + W_WGU2), D, M, 5632, D, PEpiGU{HP, (const float*)(ws + W_RSS) + (size_t)M * 16}); break;
    case 13: pgemm_head(lds, HP, DFF, (const bf16_t*)(ws + W_WD2), DFF, M, D, DFF, PEpiRes{p, 0.5f, 0, nullptr, nullptr, nullptr}); break;
    case 21: pgemm_tail(lds, HP, DFF, (const bf16_t*)(ws + W_WD2), DFF, M, D, DFF, (float*)(ws + W_VT));
        {
            const int G = (int)gridDim.x, nt_ = (((M / 256) * (D / 256)) % G) * TAIL_KS, c = (int)blockIdx.x;
            if (nt_ > 0 && nt_ < G && c >= nt_) { unsigned mask[5]; late_panels(M, D, mask, lds, tid);
                for (int pnl = c - nt_; pnl < ROW_META / 256; pnl += G - nt_) final_norm_rows(p, pnl * 256, pnl * 256 + 256, wid, 8, lane, mask, 0u); }
        }
        break;
    case 22: tail_combine(p, M, D, (const float*)(ws + W_VT), 0.5f, 0, nullptr, nullptr, nullptr, gw, ngw, lane); break;
    case 14: { unsigned mask[5]; late_panels(M, D, mask, lds, tid); const int G = (int)gridDim.x, nt_ = (((M / 256) * (D / 256)) % G) * TAIL_KS;
        if (nt_ > 0 && nt_ < G) final_norm_rows(p, 0, ROW_META, gw, ngw, lane, mask, 1u);
        else { unsigned all0[5] = {0u, 0u, 0u, 0u, 0u}; final_norm_rows(p, 0, ROW_META, gw, ngw, lane, all0, 0u); } }
        break;
    default: break;
    }
}

#if MEGA
__global__ void __launch_bounds__(512) k_fwd(Prm p) {
    extern __shared__ __attribute__((aligned(16))) unsigned char lds[];
    const int tid = threadIdx.x, lane = tid & 63, wid = __builtin_amdgcn_readfirstlane(tid >> 6);
    cg::grid_group grid = cg::this_grid();
    volatile LAS unsigned* bst = (volatile LAS unsigned*)((LAS unsigned char*)lds + (LDS_BYTES - 32));
    if (tid == 0) { bst[0] = 0u; bst[1] = 0u; }
    __syncthreads();
    const XcdBarrier xbar = xcd_barrier_post((unsigned*)(p.ws + W_BAR), bst);
#define GSYNC() xcd_barrier(xbar)
#ifndef DUP
#define DUP -1
#endif
#define RUN_PH1(n) { int t_ = tid; asm volatile("" : "+v"(t_)); run_phase(p, n, lds, t_, __builtin_amdgcn_readfirstlane(t_ >> 6), t_ & 63); }
#define RUN_PH(n) RUN_PH1(n) if (DUP == n) { grid.sync(); if (n == 8) { if (blockIdx.x == 0 && tid == 0) ((unsigned*)(p.ws + W_CTR))[0] = 0u; grid.sync(); } RUN_PH1(n) }
    if (p.pad == 0x5eed) grid.sync();
    RUN_PH(0) GSYNC(); RUN_PH(1) GSYNC(); RUN_PH(2) GSYNC(); RUN_PH(19) GSYNC(); RUN_PH(20) GSYNC(); RUN_PH(4) GSYNC(); RUN_PH(5) GSYNC(); RUN_PH(6) RUN_PH(15) RUN_PH(16) RUN_PH(17) GSYNC(); RUN_PH(7) GSYNC();
    RUN_PH(8) GSYNC(); RUN_PH(9) GSYNC(); RUN_PH(10) GSYNC(); RUN_PH(12) GSYNC(); RUN_PH(13) GSYNC(); RUN_PH(21) GSYNC(); RUN_PH(22) GSYNC(); RUN_PH(14)
}
#else
template <int PH> __global__ void __launch_bounds__(512) k_ph(Prm p) {
    extern __shared__ __attribute__((aligned(16))) unsigned char lds[];
    const int tid = threadIdx.x, lane = tid & 63, wid = __builtin_amdgcn_readfirstlane(tid >> 6);
    run_phase(p, PH, lds, tid, wid, lane);
}
template <int PH> static void launch_ph(const Prm& p, int grid, hipStream_t stream) {
    (void)hipFuncSetAttribute((const void*)k_ph<PH>, hipFuncAttributeMaxDynamicSharedMemorySize, LDS_BYTES);
    hipLaunchKernelGGL(k_ph<PH>, dim3(grid), dim3(512), LDS_BYTES, stream, p);
}
#endif

extern "C" void kernel_launch(void* const* d_in, const int* in_sizes, int n_in, void* d_out, int out_size, void* d_ws, size_t ws_size, hipStream_t stream) {
    static int grid = 0;
    if (grid == 0) {
        int dev = 0, cus = 0; (void)hipGetDevice(&dev); (void)hipDeviceGetAttribute(&cus, hipDeviceAttributeMultiprocessorCount, dev);
#if MEGA
        (void)hipFuncSetAttribute((const void*)k_fwd, hipFuncAttributeMaxDynamicSharedMemorySize, LDS_BYTES);
        int per_cu = 0; (void)hipOccupancyMaxActiveBlocksPerMultiprocessor(&per_cu, (const void*)k_fwd, 512, LDS_BYTES);
        if (per_cu < 1) fprintf(stderr, "occupancy query says %d\n", per_cu);
#endif
        grid = cus > 0 ? cus : 256;
        if (n_in != 27 || ws_size < W_END) { fprintf(stderr, "kernel_launch: unexpected n_in %d or ws_size %zu (< %zu)\n", n_in, ws_size, (size_t)W_END); }
    }
    Prm p{};
    const float** f = (const float**)&p;
    for (int i = 0; i < 27; ++i) f[i] = (const float*)d_in[i];
    p.out = (float*)d_out; p.ws = (unsigned char*)d_ws; p.phase = 0; p.pad = 0;
#if MEGA
    (void)hipMemsetAsync((char*)d_ws + W_BAR, 0, 16384, stream);
    void* args[] = {&p};
    hipError_t e = hipLaunchCooperativeKernel((const void*)k_fwd, dim3(grid), dim3(512), args, LDS_BYTES, stream);
    if (e != hipSuccess) fprintf(stderr, "cooperative launch failed: %s\n", hipGetErrorString(e));
#else
    launch_ph<0>(p, grid, stream); launch_ph<1>(p, grid, stream); launch_ph<2>(p, grid, stream); launch_ph<19>(p, grid, stream); launch_ph<20>(p, grid, stream); launch_ph<4>(p, grid, stream);
    launch_ph<5>(p, grid, stream); launch_ph<6>(p, grid, stream); launch_ph<15>(p, grid, stream); launch_ph<16>(p, grid, stream); launch_ph<17>(p, grid, stream); launch_ph<7>(p, grid, stream); launch_ph<8>(p, grid, stream); launch_ph<9>(p, grid, stream);
    launch_ph<10>(p, grid, stream); launch_ph<12>(p, grid, stream); launch_ph<13>(p, grid, stream); launch_ph<21>(p, grid, stream); launch_ph<22>(p, grid, stream); launch_ph<14>(p, grid, stream);
#endif
}
```

```cpp
#include <hip/hip_runtime.h>
#include <hip/hip_cooperative_groups.h>
#include <stdint.h>
#include <cstdio>
namespace cg = cooperative_groups;

typedef unsigned short bf16_t;
typedef short bf16x8 __attribute__((ext_vector_type(8)));
typedef short s16x4 __attribute__((ext_vector_type(4)));
typedef float f32x16 __attribute__((ext_vector_type(16)));
typedef float f32x4 __attribute__((ext_vector_type(4)));
typedef float f32x2 __attribute__((ext_vector_type(2)));
typedef unsigned u32x4 __attribute__((ext_vector_type(4)));
typedef unsigned u32x2 __attribute__((ext_vector_type(2)));
typedef __bf16 bf16x2_t __attribute__((ext_vector_type(2)));
#define DI __device__ __forceinline__
#define MFMA32(a, b, c) __builtin_amdgcn_mfma_f32_32x32x16_bf16((a), (b), (c), 0, 0, 0)

#ifndef MEGA
#define MEGA 1
#endif

constexpr int D = 1024, DFF = 2816, NPJ = 2816;
constexpr int M = 35072, ROW_S = 32768, ROW_META = 34816, ROW_PAD = 34880;
constexpr int C_Z = 1536, C_CQ = 2048, C_CKV = 2432, C_KR = 2688, C_A = 2752, C_B = 2756;
constexpr int NKEY_S = 2128;
constexpr int NTB = 2192;
constexpr float QSCALE = 0.07216878364870322f * 1.4426950408889634f;

constexpr size_t O_YS = 33554432, O_PCKV = 35651584, O_PKR = 44056576, O_PGDN = 46157824, O_PCONV = 46419968,
                 O_SCKV = 46438400, O_SKR = 46962688, O_SGDN = 47093760, O_SCONV = 49190912;
constexpr size_t al(size_t x) { return (x + 255) & ~(size_t)255; }
constexpr size_t W_XT = 0;
constexpr size_t W_CTR = al(W_XT + 256 * 1024 * 4);
constexpr size_t W_BAR = al(W_CTR + 4096);
constexpr size_t W_TBL = al(W_BAR + 16384);
constexpr size_t W_RSS = al(W_TBL + (size_t)8208 * 64 * 4);
constexpr size_t W_XN = al(W_RSS + (size_t)2 * M * 16 * 4);
constexpr size_t W_HP = al(W_XN + (size_t)M * 1024 * 2);
constexpr size_t W_WGU1 = al(W_HP + (size_t)M * 2816 * 2);
constexpr size_t W_WD1 = al(W_WGU1 + (size_t)5632 * 1024 * 2);
constexpr size_t W_WIN = al(W_WD1 + (size_t)1024 * 2816 * 2);
constexpr size_t W_HALO = W_WGU1;
constexpr size_t W_WO = al(W_WIN + (size_t)2816 * 1024 * 2);
constexpr size_t W_WUQ = al(W_WO + (size_t)1024 * 1024 * 2);
constexpr size_t W_WKN = al(W_WUQ + (size_t)768 * 384 * 2);
constexpr size_t W_WVT = al(W_WKN + (size_t)512 * 256 * 2);
constexpr size_t W_WUKV = al(W_WVT + (size_t)512 * 256 * 2);
constexpr size_t W_WGU2 = al(W_WUKV + (size_t)256 * 1024 * 2);
constexpr size_t W_WD2 = al(W_WGU2 + (size_t)5632 * 1024 * 2);
constexpr size_t W_Q = al(W_WD2 + (size_t)1024 * 2816 * 2);
constexpr size_t W_KN = al(W_Q + (size_t)M * 768 * 2);
constexpr size_t W_VT = al(W_KN + (size_t)M * 512 * 2);
constexpr size_t EXB = 24832;
constexpr size_t W_EX = al(W_VT + (size_t)M * 512 * 2);
constexpr size_t W_METAX = al(W_EX + (size_t)NTB * EXB);
constexpr size_t W_QS = al(W_METAX + (size_t)16 * 3 * 8192 * 2);
constexpr size_t W_OL = al(W_QS + (size_t)2048 * 1024 * 2);
constexpr size_t W_END = al(W_OL + (size_t)2048 * 1024 * 2);
static_assert((size_t)4 * 129 * 3 * 1536 * 2 <= W_WO - W_WGU1, "halo overlay");
static_assert(W_END <= 536870912ull, "workspace");

constexpr int LDS_BYTES = 147456;

struct Prm {
    const float *x_prompt, *x_sample, *cache_ckv, *cache_kr, *state_gdn, *state_conv, *meta, *ffn1_norm, *ffn1_wg, *ffn1_wu, *ffn1_wd,
        *mix_norm, *w_in, *conv_w, *a_log, *dt_bias, *gdn_norm, *q_norm, *kv_norm, *w_uq, *w_ukv, *w_out, *ffn2_norm, *ffn2_wg, *ffn2_wu,
        *ffn2_wd, *final_norm;
    float* out;
    unsigned char* ws;
    int phase, pad;
};

DI unsigned pk2(float lo, float hi) { f32x2 v = {lo, hi}; bf16x2_t b = __builtin_convertvector(v, bf16x2_t); return __builtin_bit_cast(unsigned, b); }
DI bf16_t f2bf(float f) { return (bf16_t)(pk2(f, 0.f) & 0xffffu); }
DI float bf2f(bf16_t h) { return __uint_as_float(((unsigned)h) << 16); }
DI float bflo(unsigned u) { return __uint_as_float(u << 16); }
DI float bfhi(unsigned u) { return __uint_as_float(u & 0xffff0000u); }
DI float wave_sum(float v) {
    v += __int_as_float(__builtin_amdgcn_update_dpp(0, __float_as_int(v), 0xB1, 0xF, 0xF, true));
    v += __int_as_float(__builtin_amdgcn_update_dpp(0, __float_as_int(v), 0x4E, 0xF, 0xF, true));
    v += __int_as_float(__builtin_amdgcn_update_dpp(0, __float_as_int(v), 0x141, 0xF, 0xF, true));
    v += __int_as_float(__builtin_amdgcn_update_dpp(0, __float_as_int(v), 0x140, 0xF, 0xF, true));
    const float r0 = __int_as_float(__builtin_amdgcn_readlane(__float_as_int(v), 0)), r1 = __int_as_float(__builtin_amdgcn_readlane(__float_as_int(v), 16));
    const float r2 = __int_as_float(__builtin_amdgcn_readlane(__float_as_int(v), 32)), r3 = __int_as_float(__builtin_amdgcn_readlane(__float_as_int(v), 48));
    return (r0 + r1) + (r2 + r3);
}
DI float xhalf_max(float v) { const auto r = __builtin_amdgcn_permlane32_swap(__float_as_uint(v), __float_as_uint(v), false, false); return fmaxf(__uint_as_float(r[0]), __uint_as_float(r[1])); }
DI float xhalf_sum(float v) { const auto r = __builtin_amdgcn_permlane32_swap(__float_as_uint(v), __float_as_uint(v), false, false); return __uint_as_float(r[0]) + __uint_as_float(r[1]); }
DI float row16_sum(float v) {
    v += __int_as_float(__builtin_amdgcn_update_dpp(0, __float_as_int(v), 0xB1, 0xF, 0xF, true));
    v += __int_as_float(__builtin_amdgcn_update_dpp(0, __float_as_int(v), 0x4E, 0xF, 0xF, true));
    v += __int_as_float(__builtin_amdgcn_update_dpp(0, __float_as_int(v), 0x141, 0xF, 0xF, true));
    v += __int_as_float(__builtin_amdgcn_update_dpp(0, __float_as_int(v), 0x140, 0xF, 0xF, true));
    return v;
}
DI float rss_rstd(const float* rss, int r) {
    const f32x4* q = (const f32x4*)(rss + (size_t)r * 16); const f32x4 a = q[0], b = q[1], c = q[2], d = q[3];
    const float ss = ((a.x + a.y) + (a.z + a.w)) + ((b.x + b.y) + (b.z + b.w)) + (((c.x + c.y) + (c.z + c.w)) + ((d.x + d.y) + (d.z + d.w)));
    return rsqrtf(ss * (1.f / 1024.f) + 1e-6f);
}
DI float siluf(float x) { return x * __builtin_amdgcn_rcpf(1.f + __expf(-x)); }
DI float* xrow(const Prm& p, int r) { return r < ROW_META ? p.out + (size_t)r * D : (float*)(p.ws + W_XT) + (size_t)(r - ROW_META) * D; }
DI const float* x0row(const Prm& p, int r) { return r < ROW_S ? p.x_prompt + (size_t)r * D : (r < ROW_META ? p.x_sample + (size_t)(r - ROW_S) * D : (r < ROW_PAD ? p.meta + (size_t)((r - ROW_META) & 15) * D : nullptr)); }
DI int rowpos(int r) { return r < ROW_S ? 16 + (r & 8191) : (r < ROW_META ? 2064 + ((r - ROW_S) & 63) : ((r - ROW_META) & 15)); }
DI bf16x8 packs(const f32x16& x, int s) {
    u32x4 w;
    w.x = pk2(x[8 * s + 0], x[8 * s + 1]); w.y = pk2(x[8 * s + 2], x[8 * s + 3]);
    w.z = pk2(x[8 * s + 4], x[8 * s + 5]); w.w = pk2(x[8 * s + 6], x[8 * s + 7]);
    return __builtin_bit_cast(bf16x8, w);
}
DI bf16x8 ld_perm(const bf16_t* p) {
    s16x4 a = *(const s16x4*)p, b = *(const s16x4*)(p + 8);
    bf16x8 r; r[0] = a[0]; r[1] = a[1]; r[2] = a[2]; r[3] = a[3]; r[4] = b[0]; r[5] = b[1]; r[6] = b[2]; r[7] = b[3];
    return r;
}

template <class F> DI void cvt_w(bf16_t* dst, int K, int Nout, const float* src, int ldsrc, F colmap, int gt, int ngt) {
    const int kc = K / 8; const long items = (long)Nout * kc;
    for (long it = gt; it < items; it += ngt) {
        const int n = (int)(it % Nout), k0 = (int)(it / Nout) * 8; const int c = colmap(n);
        float v[8];
#pragma unroll
        for (int j = 0; j < 8; ++j) v[j] = c >= 0 ? src[(size_t)(k0 + j) * ldsrc + c] : 0.f;
        u32x4 w; w.x = pk2(v[0], v[1]); w.y = pk2(v[2], v[3]); w.z = pk2(v[4], v[5]); w.w = pk2(v[6], v[7]);
        *(u32x4*)(dst + (size_t)n * K + k0) = w;
    }
}
DI void norm_rows(const Prm& p, int mode, const float* gain, int gw, int ngw, int lane) {
    bf16_t* XN = (bf16_t*)(p.ws + W_XN);
    for (int r = gw; r < M; r += ngw) {
        const float* src = nullptr;
        if (mode == 0) { if (r < ROW_S) src = p.x_prompt + (size_t)r * D; else if (r < ROW_META) src = p.x_sample + (size_t)(r - ROW_S) * D; else if (r < ROW_PAD) src = p.meta + (size_t)((r - ROW_META) & 15) * D; }
        else src = xrow(p, r);
        f32x4 v[4]; float ss = 0.f;
#pragma unroll
        for (int j = 0; j < 4; ++j) { v[j] = src ? ((const f32x4*)src)[lane + 64 * j] : (f32x4){0.f, 0.f, 0.f, 0.f}; ss += v[j].x * v[j].x + v[j].y * v[j].y + v[j].z * v[j].z + v[j].w * v[j].w; }
        ss = wave_sum(ss); const float rstd = rsqrtf(ss * (1.f / D) + 1e-6f);
#pragma unroll
        for (int j = 0; j < 4; ++j) { const f32x4 g = ((const f32x4*)gain)[lane + 64 * j]; u32x2 w; w.x = pk2(v[j].x * rstd * g.x, v[j].y * rstd * g.y); w.y = pk2(v[j].z * rstd * g.z, v[j].w * rstd * g.w);
            ((u32x2*)(XN + (size_t)r * D))[lane + 64 * j] = w; }
    }
}
DI void final_norm_rows(const Prm& p, int r0, int r1, int gw, int ngw, int lane, const unsigned (&mask)[5], unsigned want) {
    for (int r = r0 + gw; r < r1; r += ngw) {
        const int pn_ = r >> 8; if (((mask[pn_ >> 5] >> (pn_ & 31)) & 1u) != want) continue;
        float* x = p.out + (size_t)r * D; f32x4 v[4]; float ss = 0.f;
#pragma unroll
        for (int j = 0; j < 4; ++j) { v[j] = ((const f32x4*)x)[lane + 64 * j]; ss += v[j].x * v[j].x + v[j].y * v[j].y + v[j].z * v[j].z + v[j].w * v[j].w; }
        ss = wave_sum(ss); const float rstd = rsqrtf(ss * (1.f / D) + 1e-6f);
#pragma unroll
        for (int j = 0; j < 4; ++j) { const f32x4 g = ((const f32x4*)p.final_norm)[lane + 64 * j]; ((f32x4*)x)[lane + 64 * j] = (f32x4){v[j].x * rstd * g.x, v[j].y * rstd * g.y, v[j].z * rstd * g.z, v[j].w * rstd * g.w}; }
    }
}
DI void cvt_ffn(const Prm& p, int l, int gt, int ngt, int parts = 3) {
    unsigned char* ws = p.ws;
    const float *wg = l ? p.ffn2_wg : p.ffn1_wg, *wu = l ? p.ffn2_wu : p.ffn1_wu, *wd = l ? p.ffn2_wd : p.ffn1_wd;
    bf16_t* dgu = (bf16_t*)(ws + (l ? W_WGU2 : W_WGU1)); bf16_t* dd = (bf16_t*)(ws + (l ? W_WD2 : W_WD1));
    const long du = wu - wg;
    if (parts & 1) { const long items = (long)(5632 / 4) * (D / 8);
        for (long it = gt; it < items; it += ngt) { const int n = 4 * (int)(it % 1408), k0 = (int)(it / 1408) * 8; const int blk = n >> 8, r = n & 255; const float* s = wg + (r < 128 ? 0l : du) + blk * 128 + (r & 127);
            f32x4 v[8];
#pragma unroll
            for (int j = 0; j < 8; ++j) v[j] = *(const f32x4*)(s + (size_t)(k0 + j) * DFF);
#pragma unroll
            for (int i = 0; i < 4; ++i) { u32x4 w; w.x = pk2(v[0][i], v[1][i]); w.y = pk2(v[2][i], v[3][i]); w.z = pk2(v[4][i], v[5][i]); w.w = pk2(v[6][i], v[7][i]); *(u32x4*)(dgu + (size_t)(n + i) * D + k0) = w; } } }
    if (parts & 2) { const long items = (long)(D / 4) * (DFF / 8);
        for (long it = gt; it < items; it += ngt) { const int n = 4 * (int)(it % 256), k0 = (int)(it / 256) * 8;
            f32x4 v[8];
#pragma unroll
            for (int j = 0; j < 8; ++j) v[j] = *(const f32x4*)(wd + (size_t)(k0 + j) * D + n);
#pragma unroll
            for (int i = 0; i < 4; ++i) { u32x4 w; w.x = pk2(v[0][i], v[1][i]); w.y = pk2(v[2][i], v[3][i]); w.z = pk2(v[4][i], v[5][i]); w.w = pk2(v[6][i], v[7][i]); *(u32x4*)(dd + (size_t)(n + i) * DFF + k0) = w; } } }
}
DI void prep_late(const Prm& p, int gt, int ngt) {
    unsigned char* ws = p.ws;
    cvt_w((bf16_t*)(ws + W_WIN), D, NPJ, p.w_in, 2760, [](int n) {
        if (n < 2048) return n; if (n < C_KR) return n + 8;
        if (n < C_A) { const int q = n - C_KR; return 2696 + (q >> 1) + 32 * (q & 1); }
        if (n < C_A + 4) return 2048 + (n - C_A); if (n < C_B + 4) return 2052 + (n - C_B); return -1; }, gt, ngt);
    cvt_w((bf16_t*)(ws + W_WO), D, D, p.w_out, D, [](int n) { return n; }, gt, ngt);
    cvt_w((bf16_t*)(ws + W_WUQ), 384, 768, p.w_uq, 768, [](int n) { const int h = n / 192, j = n % 192; if (j < 128) return n; const int q = j - 128; return h * 192 + 128 + (q >> 1) + 32 * (q & 1); }, gt, ngt);
    cvt_w((bf16_t*)(ws + W_WKN), 256, 512, p.w_ukv, 1024, [](int n) { return (n >> 7) * 256 + (n & 127); }, gt, ngt);
    cvt_w((bf16_t*)(ws + W_WVT), 256, 512, p.w_ukv, 1024, [](int n) { return (n >> 7) * 256 + 128 + (n & 127); }, gt, ngt);
    {
        bf16_t* d = (bf16_t*)(ws + W_WUKV);
        for (int i = gt; i < 256 * 1024 / 4; i += ngt) { const f32x4 v = ((const f32x4*)p.w_ukv)[i]; u32x2 w; w.x = pk2(v.x, v.y); w.y = pk2(v.z, v.w); ((u32x2*)d)[i] = w; }
    }
    cvt_ffn(p, 1, gt, ngt);
}
DI void phase_prep(const Prm& p, int tid, int lane, int wid) {
    const int gt = blockIdx.x * 512 + tid, ngt = gridDim.x * 512, gw = blockIdx.x * 8 + wid, ngw = gridDim.x * 8;
    unsigned char* ws = p.ws;
    if (gt < 8) ((unsigned*)(ws + W_CTR))[64 * gt] = 0u;
    cvt_ffn(p, 0, gt, ngt, 1);
    {
        float* tb = (float*)(ws + W_TBL);
        for (int it = gt; it < 8208 * 32; it += ngt) { const int pos = it >> 5, i = it & 31; const float inv = exp2f(-(float)i * (13.287712379549449f / 32.f)); float s, c; sincosf((float)pos * inv, &s, &c); tb[pos * 64 + i] = c; tb[pos * 64 + 32 + i] = s; }
    }
    norm_rows(p, 0, p.ffn1_norm, gw, ngw, lane);
}

template <class Epi> DI void gemm_simple(const bf16_t* A, int lda, const bf16_t* Bt, int ldb, int Mg, int Ng, int K, const Epi& epi, int gw, int ngw, int lane) {
    const int TN = Ng / 64, TM = Mg / 64, lr = lane & 31, hi = lane >> 5;
    for (int idx = gw; idx < TM * TN; idx += ngw) {
        const int tm = idx / TN, tn = idx % TN, m0 = tm * 64, n0 = tn * 64;
        f32x16 acc[2][2];
#pragma unroll
        for (int a = 0; a < 2; ++a)
#pragma unroll
            for (int b = 0; b < 2; ++b)
#pragma unroll
                for (int i = 0; i < 16; ++i) acc[a][b][i] = 0.f;
        const bf16_t* ap = A + (size_t)(m0 + lr) * lda + 8 * hi;
        const bf16_t* bp = Bt + (size_t)(n0 + lr) * ldb + 8 * hi;
        const size_t a32 = (size_t)32 * lda, b32 = (size_t)32 * ldb;
#pragma unroll 4
        for (int k = 0; k < K; k += 16) {
            const bf16x8 a0 = *(const bf16x8*)(ap + k), a1 = *(const bf16x8*)(ap + a32 + k);
            const bf16x8 b0 = *(const bf16x8*)(bp + k), b1 = *(const bf16x8*)(bp + b32 + k);
            acc[0][0] = MFMA32(b0, a0, acc[0][0]); acc[0][1] = MFMA32(b1, a0, acc[0][1]);
            acc[1][0] = MFMA32(b0, a1, acc[1][0]); acc[1][1] = MFMA32(b1, a1, acc[1][1]);
        }
        epi(acc, m0, n0, lr, hi);
    }
}
struct EpiGU {
    bf16_t* H;
    DI void operator()(const f32x16 (&acc)[2][2], int m0, int n0, int lr, int hi) const {
#pragma unroll
        for (int mi = 0; mi < 2; ++mi) { bf16_t* row = H + (size_t)(m0 + 32 * mi + lr) * DFF + (n0 >> 1) + 4 * hi;
#pragma unroll
            for (int g = 0; g < 4; ++g) { float v[4];
#pragma unroll
                for (int e = 0; e < 4; ++e) v[e] = siluf(acc[mi][0][4 * g + e]) * acc[mi][1][4 * g + e];
                u32x2 w; w.x = pk2(v[0], v[1]); w.y = pk2(v[2], v[3]); *(u32x2*)(row + 8 * g) = w; } }
    }
};
struct EpiRes {
    Prm p; float alpha;
    DI void operator()(const f32x16 (&acc)[2][2], int m0, int n0, int lr, int hi) const {
#pragma unroll
        for (int mi = 0; mi < 2; ++mi) { float* row = xrow(p, m0 + 32 * mi + lr) + n0 + 4 * hi;
#pragma unroll
            for (int ni = 0; ni < 2; ++ni)
#pragma unroll
                for (int g = 0; g < 4; ++g) { f32x4* q = (f32x4*)(row + 32 * ni + 8 * g); f32x4 x = *q;
                    x.x += alpha * acc[mi][ni][4 * g]; x.y += alpha * acc[mi][ni][4 * g + 1]; x.z += alpha * acc[mi][ni][4 * g + 2]; x.w += alpha * acc[mi][ni][4 * g + 3]; *q = x; } }
    }
};
struct EpiBf {
    bf16_t* O; int ldc;
    DI void operator()(const f32x16 (&acc)[2][2], int m0, int n0, int lr, int hi) const {
#pragma unroll
        for (int mi = 0; mi < 2; ++mi) { bf16_t* row = O + (size_t)(m0 + 32 * mi + lr) * ldc + n0 + 4 * hi;
#pragma unroll
            for (int ni = 0; ni < 2; ++ni)
#pragma unroll
                for (int g = 0; g < 4; ++g) { u32x2 w; w.x = pk2(acc[mi][ni][4 * g], acc[mi][ni][4 * g + 1]); w.y = pk2(acc[mi][ni][4 * g + 2], acc[mi][ni][4 * g + 3]); *(u32x2*)(row + 32 * ni + 8 * g) = w; } }
    }
};
struct EpiQ {
    bf16_t* Q; const float* tbl;
    DI void operator()(const f32x16 (&acc)[2][2], int m0, int n0, int lr, int hi) const {
        const bool rope = ((n0 >> 6) % 3) == 2;
#pragma unroll
        for (int mi = 0; mi < 2; ++mi) { const int r = m0 + 32 * mi + lr; bf16_t* row = Q + (size_t)r * 768 + n0 + 4 * hi; const float* tb = tbl + (size_t)rowpos(r) * 64;
#pragma unroll
            for (int ni = 0; ni < 2; ++ni)
#pragma unroll
                for (int g = 0; g < 4; ++g) { float v0 = acc[mi][ni][4 * g], v1 = acc[mi][ni][4 * g + 1], v2 = acc[mi][ni][4 * g + 2], v3 = acc[mi][ni][4 * g + 3];
                    if (rope) { const int i0 = (32 * ni + 8 * g + 4 * hi) >> 1; const float c0 = tb[i0], s0 = tb[32 + i0], c1 = tb[i0 + 1], s1 = tb[33 + i0];
                        const float a0 = v0 * c0 - v1 * s0, b0 = v1 * c0 + v0 * s0, a1 = v2 * c1 - v3 * s1, b1 = v3 * c1 + v2 * s1; v0 = a0; v1 = b0; v2 = a1; v3 = b1; }
                    u32x2 w; w.x = pk2(v0 * QSCALE, v1 * QSCALE); w.y = pk2(v2 * QSCALE, v3 * QSCALE); *(u32x2*)(row + 32 * ni + 8 * g) = w; } }
    }
};

DI void phase_post(const Prm& p, int gw, int ngw, int lane) {
    bf16_t* HP = (bf16_t*)(p.ws + W_HP); bf16_t* halo = (bf16_t*)(p.ws + W_HALO); const float* tbl = (const float*)(p.ws + W_TBL);
    for (int r = gw; r < ROW_PAD; r += ngw) {
        bf16_t* row = HP + (size_t)r * NPJ;
        int ck_row, sidx = -1;
        float *ockv, *okr;
        if (r < ROW_S) { const int b = r >> 13, t = r & 8191; ck_row = b * 8208 + 16 + t; ockv = p.out + O_PCKV + (size_t)ck_row * 256; okr = p.out + O_PKR + (size_t)ck_row * 64; }
        else if (r < ROW_META) { sidx = r - ROW_S; ockv = p.out + O_SCKV + (size_t)sidx * 256; okr = p.out + O_SKR + (size_t)sidx * 64; }
        else { const int b = (r - ROW_META) >> 4, i = (r - ROW_META) & 15; ck_row = b * 8208 + i; ockv = p.out + O_PCKV + (size_t)ck_row * 256; okr = p.out + O_PKR + (size_t)ck_row * 64; }
        { unsigned* q = (unsigned*)(row + C_CQ); unsigned u[3]; float ss = 0.f;
#pragma unroll
          for (int j = 0; j < 3; ++j) { u[j] = q[lane + 64 * j]; const float a = bflo(u[j]), b = bfhi(u[j]); ss += a * a + b * b; }
          ss = wave_sum(ss); const float rstd = rsqrtf(ss * (1.f / 384.f) + 1e-6f);
#pragma unroll
          for (int j = 0; j < 3; ++j) { const int c = 2 * (lane + 64 * j); q[lane + 64 * j] = pk2(bflo(u[j]) * rstd * p.q_norm[c], bfhi(u[j]) * rstd * p.q_norm[c + 1]); } }
        { u32x2* q = (u32x2*)(row + C_CKV) + lane; const u32x2 u = *q; float v[4] = {bflo(u.x), bfhi(u.x), bflo(u.y), bfhi(u.y)};
          float ss = v[0] * v[0] + v[1] * v[1] + v[2] * v[2] + v[3] * v[3]; ss = wave_sum(ss); const float rstd = rsqrtf(ss * (1.f / 256.f) + 1e-6f);
          const f32x4 g = ((const f32x4*)p.kv_norm)[lane]; f32x4 c = {v[0] * rstd * g.x, v[1] * rstd * g.y, v[2] * rstd * g.z, v[3] * rstd * g.w};
          ((f32x4*)ockv)[lane] = c; u32x2 w; w.x = pk2(c.x, c.y); w.y = pk2(c.z, c.w); *q = w; }
        if (lane < 32) { unsigned* q = (unsigned*)(row + C_KR) + lane; const unsigned u = *q; const float x1 = bflo(u), x2 = bfhi(u); const float* tb = tbl + (size_t)rowpos(r) * 64; const float c = tb[lane], s = tb[32 + lane];
            const float o1 = x1 * c - x2 * s, o2 = x2 * c + x1 * s; okr[lane] = o1; okr[32 + lane] = o2; const unsigned w = pk2(o1, o2); *q = w; }
        { int hb = -1, hc = 0, hj = 0;
          if (r < ROW_S) { const int t = r & 8191; if ((t & 63) >= 61 && t < 8128) { hb = r >> 13; hc = (t >> 6) + 2; hj = (t & 63) - 61; } }
          else if (r >= ROW_META && ((r - ROW_META) & 15) >= 13) { hb = (r - ROW_META) >> 4; hc = 1; hj = ((r - ROW_META) & 15) - 13; }
          if (hb >= 0) { unsigned* hd = (unsigned*)(halo + (((size_t)hb * 129 + hc) * 3 + hj) * 1536); for (int c = lane; c < 768; c += 64) hd[c] = ((const unsigned*)row)[c]; } }
        if (r < ROW_S && (r & 8191) >= 8189) { float* o = p.out + O_PCONV + ((size_t)(r >> 13) * 3 + ((r & 8191) - 8189)) * 1536;
            for (int c = lane; c < 768; c += 64) { const unsigned u = ((const unsigned*)row)[c]; o[2 * c] = bflo(u); o[2 * c + 1] = bfhi(u); } }
        if (sidx >= 0 && (sidx & 63) >= 61) { float* o = p.out + O_SCONV + ((size_t)(sidx >> 6) * 3 + ((sidx & 63) - 61)) * 1536;
            for (int c = lane; c < 768; c += 64) { const unsigned u = ((const unsigned*)row)[c]; o[2 * c] = bflo(u); o[2 * c + 1] = bfhi(u); } }
    }
}

DI f32x2 gdn_raw(const Prm& p, int kind, int b, int c, int t_rel, int col) {
    const bf16_t* HP = (const bf16_t*)(p.ws + W_HP); int row;
    if (kind == 0) {
        if (t_rel < 0) { if (c == 0) return (f32x2){0.f, 0.f}; const unsigned u = *(const unsigned*)((const bf16_t*)(p.ws + W_HALO) + (((size_t)b * 129 + c) * 3 + (3 + t_rel)) * 1536 + col); return (f32x2){bflo(u), bfhi(u)}; }
        row = c == 0 ? ROW_META + 16 * b + t_rel : b * 8192 + 64 * (c - 1) + t_rel;
    } else {
        if (t_rel < 0) { const float* s = p.state_conv + ((size_t)b * 3 + (3 + t_rel)) * 1536 + col; return (f32x2){s[0], s[1]}; }
        row = ROW_S + 64 * b + t_rel;
    }
    const unsigned u = *(const unsigned*)(HP + (size_t)row * NPJ + col); return (f32x2){bflo(u), bfhi(u)};
}
DI bf16_t* gdn_slot(const Prm& p, int kind, int b, int c, int h, int which, int& ld) {
    if (kind == 0 && c == 0) { ld = 128; return (bf16_t*)(p.ws + W_METAX) + ((size_t)(b * 4 + h) * 3 + which) * 8192; }
    ld = NPJ; const int row0 = kind == 0 ? b * 8192 + 64 * (c - 1) : ROW_S + 64 * b; return (bf16_t*)(p.ws + W_HP) + (size_t)row0 * NPJ + which * 512 + h * 128;
}
DI int gdn_row(int kind, int b, int c, int t) { return kind == 0 ? (c == 0 ? ROW_META + 16 * b + t : b * 8192 + 64 * (c - 1) + t) : ROW_S + 64 * b + t; }
DI void gdn_gates(const Prm& p, int kind, int b, int c, int h, int lane, float& gc, float& beta) {
    const bf16_t* HP = (const bf16_t*)(p.ws + W_HP); const int ntok = (kind == 0 && c == 0) ? 16 : 64;
    float g = 0.f; beta = 0.f;
    if (lane < ntok) { const bf16_t* row = HP + (size_t)gdn_row(kind, b, c, lane) * NPJ; const float a = bf2f(row[C_A + h]), bb = bf2f(row[C_B + h]);
        const float x = a + p.dt_bias[h]; const float sp = fmaxf(x, 0.f) + __logf(1.f + __expf(-fabsf(x))); g = -__expf(p.a_log[h]) * sp; beta = __builtin_amdgcn_rcpf(1.f + __expf(-bb)); }
#define GDN_DPP_ADD(ctrl, rmask) g += __int_as_float(__builtin_amdgcn_update_dpp(0, __float_as_int(g), ctrl, rmask, 0xF, false))
    GDN_DPP_ADD(0x111, 0xF); GDN_DPP_ADD(0x112, 0xF); GDN_DPP_ADD(0x114, 0xF); GDN_DPP_ADD(0x118, 0xF);
    GDN_DPP_ADD(0x142, 0xA);
    GDN_DPP_ADD(0x143, 0xC);
#undef GDN_DPP_ADD
    gc = g;
}
template <class F> DI void gdn_conv(const Prm& p, int kind, int b, int c, int col, int t0, int n, F f) {
    f32x2 w[4];
#pragma unroll
    for (int j = 0; j < 4; ++j) w[j] = (f32x2){p.conv_w[j * 1536 + col], p.conv_w[j * 1536 + col + 1]};
    f32x2 x0 = gdn_raw(p, kind, b, c, t0 - 3, col), x1 = gdn_raw(p, kind, b, c, t0 - 2, col), x2 = gdn_raw(p, kind, b, c, t0 - 1, col);
#pragma unroll 8
    for (int t = t0; t < t0 + n; ++t) { const f32x2 x3 = gdn_raw(p, kind, b, c, t, col);
        const float y0 = w[0].x * x0.x + w[1].x * x1.x + w[2].x * x2.x + w[3].x * x3.x, y1 = w[0].y * x0.y + w[1].y * x1.y + w[2].y * x2.y + w[3].y * x3.y;
        f(t, siluf(y0), siluf(y1)); x0 = x1; x1 = x2; x2 = x3; }
}
DI void gdn_unit_decode(int u, int& kind, int& b, int& c, int& h) { if (u < 2064) { kind = 0; b = u / 516; const int r = u % 516; c = r >> 2; h = r & 3; } else { kind = 1; b = (u - 2064) >> 2; c = 0; h = u & 3; } }

constexpr int GK_STR = 136;
constexpr int GT_STR = 72;
constexpr int GP_Q = 0, GP_K = 17408, GP_KEG = 34816, GP_VT = 53248, GP_KD = 71680, GP_TB = 90112, GP_A = 99328, GP_G = 115712;
DI void gdn_pre_unit(const Prm& p, unsigned char* lds0, int u, int tid, int wid, int lane) {
    int loff = 0; asm volatile("" : "+s"(loff)); unsigned char* lds = lds0 + loff;
    bf16_t* qL = (bf16_t*)(lds + GP_Q); bf16_t* kL = (bf16_t*)(lds + GP_K); bf16_t* kegL = (bf16_t*)(lds + GP_KEG); bf16_t* vtL = (bf16_t*)(lds + GP_VT); bf16_t* kdL = (bf16_t*)(lds + GP_KD);
    bf16_t* tbL = (bf16_t*)(lds + GP_TB); float* AL = (float*)(lds + GP_A); float* gL = (float*)(lds + GP_G);
    unsigned char* ex = p.ws + W_EX + (size_t)u * EXB;
    int kind, b, c, h; gdn_unit_decode(u, kind, b, c, h);
    const int lr = lane & 31, hi = lane >> 5;
    __syncthreads();
    if (wid == 0) { float gc, beta; gdn_gates(p, kind, b, c, h, lane, gc, beta); gL[lane] = gc; gL[64 + lane] = beta; const float eg = __expf(gc); gL[128 + lane] = eg; ((float*)(ex + 24576))[lane] = eg; }
    __syncthreads();
    const float gl = gL[63];
    if (wid < 6) { const int part = wid % 3, th = wid / 3;
        gdn_conv(p, kind, b, c, part * 512 + h * 128 + 2 * lane, 32 * th, 32, [&](int t, float y0, float y1) {
            if (part == 2) { vtL[(2 * lane) * GT_STR + t] = f2bf(y0); vtL[(2 * lane + 1) * GT_STR + t] = f2bf(y1); }
            else { const float ss = wave_sum(y0 * y0 + y1 * y1); float rn = rsqrtf(ss + 1e-6f);
                if (part == 0) { rn *= 0.08838834764831845f; *(unsigned*)(qL + t * GK_STR + 2 * lane) = pk2(y0 * rn, y1 * rn); }
                else { const float k0 = y0 * rn, k1 = y1 * rn; *(unsigned*)(kL + t * GK_STR + 2 * lane) = pk2(k0, k1); const float eg = gL[128 + t], ed = __expf(gl - gL[t]);
                    kegL[(2 * lane) * GT_STR + t] = f2bf(k0 * eg); kegL[(2 * lane + 1) * GT_STR + t] = f2bf(k1 * eg); kdL[(2 * lane) * GT_STR + t] = f2bf(k0 * ed); kdL[(2 * lane + 1) * GT_STR + t] = f2bf(k1 * ed); } } });
    }
    __syncthreads();
    if (wid < 6) {
        const int q = wid % 3, tb = q ? 1 : 0, sb = q == 2 ? 1 : 0; const bf16_t* aL = wid < 3 ? kL : qL;
        f32x16 acc;
#pragma unroll
        for (int i = 0; i < 16; ++i) acc[i] = 0.f;
#pragma unroll
        for (int ks = 0; ks < 8; ++ks) { const bf16x8 a = *(const bf16x8*)(aL + (32 * tb + lr) * GK_STR + 16 * ks + 8 * hi), bb = *(const bf16x8*)(kL + (32 * sb + lr) * GK_STR + 16 * ks + 8 * hi); acc = MFMA32(a, bb, acc); }
        const int s_ = 32 * sb + lr; const float gs = gL[s_];
        if (wid < 3) {
            const int sp = (s_ & 3) * 16 + (s_ >> 2), sp2 = ((32 + lr) & 3) * 16 + ((32 + lr) >> 2);
#pragma unroll
            for (int i = 0; i < 16; ++i) { const int t = 32 * tb + (i & 3) + 8 * (i >> 2) + 4 * hi; AL[t * 64 + sp] = (s_ < t) ? gL[64 + t] * acc[i] * __expf(gL[t] - gs) : 0.f; if (q == 0) AL[t * 64 + sp2] = 0.f; }
        } else { bf16_t* qk = (bf16_t*)(ex + 16384);
#pragma unroll
            for (int i = 0; i < 16; ++i) { const int t = 32 * tb + (i & 3) + 8 * (i >> 2) + 4 * hi; qk[t * 64 + s_] = f2bf(s_ <= t ? acc[i] * __expf(gL[t] - gs) : 0.f); if (q == 0) qk[t * 64 + 32 + lr] = 0; }
        }
    }
    __syncthreads();
    if (wid < 4) {
        const int c = 16 * wid + (lane >> 2), pp = lane & 3; const float beta = gL[64 + c];
        float Tp[16];
#pragma unroll
        for (int j = 0; j < 16; ++j) Tp[j] = 0.f;
#pragma unroll
        for (int t = 0; t < 64; ++t) { float a = 0.f;
#pragma unroll
            for (int j4 = 0; j4 < (t + 15) / 16; ++j4) { const f32x4 av = *(const f32x4*)(AL + t * 64 + pp * 16 + 4 * j4);
                a += av.x * Tp[4 * j4]; a += av.y * Tp[4 * j4 + 1]; a += av.z * Tp[4 * j4 + 2]; a += av.w * Tp[4 * j4 + 3]; }
            a += __int_as_float(__builtin_amdgcn_update_dpp(0, __float_as_int(a), 0xB1, 0xF, 0xF, true));
            a += __int_as_float(__builtin_amdgcn_update_dpp(0, __float_as_int(a), 0x4E, 0xF, 0xF, true));
            const float Tt = (t == c ? 1.f : 0.f) - a;
            if (pp == (t & 3)) Tp[t >> 2] = Tt;
            if (pp == 0) tbL[t * GT_STR + c] = f2bf(Tt * beta);
        }
    }
    __syncthreads();
    {
        f32x16 uu[2];
#pragma unroll
        for (int tb = 0; tb < 2; ++tb)
#pragma unroll
            for (int i = 0; i < 16; ++i) uu[tb][i] = 0.f;
        const bf16_t* bsrc = (wid < 4 ? vtL : kegL) + (32 * (wid & 3) + lr) * GT_STR + 8 * hi;
#pragma unroll
        for (int ks = 0; ks < 4; ++ks) { const bf16x8 bf = *(const bf16x8*)(bsrc + 16 * ks);
            const bf16x8 a0 = *(const bf16x8*)(tbL + lr * GT_STR + 16 * ks + 8 * hi), a1 = *(const bf16x8*)(tbL + (32 + lr) * GT_STR + 16 * ks + 8 * hi);
            uu[0] = MFMA32(a0, bf, uu[0]); uu[1] = MFMA32(a1, bf, uu[1]); }
        if (wid < 4) {
#pragma unroll
            for (int tb = 0; tb < 2; ++tb) { u32x4* d = (u32x4*)(ex + ((size_t)((wid * 2 + tb) * 64 + lane)) * 32);
                d[0] = __builtin_bit_cast(u32x4, packs(uu[tb], 0)); d[1] = __builtin_bit_cast(u32x4, packs(uu[tb], 1)); }
        } else { int ld; bf16_t* wg = gdn_slot(p, kind, b, c, h, 1, ld);
#pragma unroll
            for (int tb = 0; tb < 2; ++tb)
#pragma unroll
                for (int i = 0; i < 16; ++i) { const int t = 32 * tb + (i & 3) + 8 * (i >> 2) + 4 * hi; wg[(size_t)t * ld + 32 * (wid & 3) + lr] = f2bf(-uu[tb][i]); }
        }
    }
    {
        int ld; bf16_t* qg = gdn_slot(p, kind, b, c, h, 0, ld); bf16_t* kg = gdn_slot(p, kind, b, c, h, 2, ld);
#pragma unroll
        for (int i = 0; i < 2; ++i) { const int e = tid + 512 * i, row = e >> 4, cc = e & 15; *(u32x4*)(qg + (size_t)row * ld + 8 * cc) = *(const u32x4*)(qL + row * GK_STR + 8 * cc);
            const int dk = 2 * row + (cc >> 3); *(u32x4*)(kg + (size_t)row * ld + 8 * cc) = *(const u32x4*)(kdL + dk * GT_STR + 8 * (cc & 7)); }
    }
}
DI void phase_gdn_pre(const Prm& p, unsigned char* lds, int tid, int wid, int lane) {
    for (int u = blockIdx.x; u < NTB; u += gridDim.x) { int lv = lane, tv = tid; asm volatile("" : "+v"(lv), "+v"(tv)); gdn_pre_unit(p, lds, u, tv, wid, lv); }
    __syncthreads();
}

constexpr int GS_Q = 0, GS_W = 17408, GS_KD = 34816, GS_QK = 53248, GS_EG = 62464;
DI void gdn_scan_unit(const Prm& p, unsigned char* lds, int kind, int b, int h, int tid, int wid, int lane) {
    bf16_t* O = (bf16_t*)(p.ws + W_XN);
    const int lr = lane & 31, hi = lane >> 5, nch = kind == 0 ? 129 : 1;
    f32x16 Mst[4];
    const int dv = 32 * (wid & 3) + lr;
    constexpr int GS_BUF = 62720;
    u32x4 lsE[14], lsO[14], u0E[4], u0O[4]; float egE = 0.f, egO = 0.f;
    const int lt = tid - 256;
    auto lissue = [&](int c, u32x4 (&ls)[14], float& eg) {
        if (c >= nch) return;
        const int u = kind == 0 ? b * 516 + c * 4 + h : 2064 + b * 4 + h; const unsigned char* ex = p.ws + W_EX + (size_t)u * EXB;
        int ld; const bf16_t* qg = gdn_slot(p, kind, b, c, h, 0, ld); const bf16_t* wg = gdn_slot(p, kind, b, c, h, 1, ld); const bf16_t* kg = gdn_slot(p, kind, b, c, h, 2, ld);
#pragma unroll
        for (int i = 0; i < 4; ++i) { const int e = lt + 256 * i, row = e >> 4, cc = e & 15; ls[i] = *(const u32x4*)(qg + (size_t)row * ld + 8 * cc); ls[4 + i] = *(const u32x4*)(wg + (size_t)row * ld + 8 * cc); ls[8 + i] = *(const u32x4*)(kg + (size_t)row * ld + 8 * cc); }
#pragma unroll
        for (int i = 0; i < 2; ++i) ls[12 + i] = *(const u32x4*)(ex + 16384 + (size_t)(lt + 256 * i) * 16);
        if (lt < 64) eg = ((const float*)(ex + 24576))[lt];
    };
    auto lstore = [&](int buf, const u32x4 (&ls)[14], float eg) {
        unsigned char* lb = lds + buf * GS_BUF; bf16_t* qB = (bf16_t*)(lb + GS_Q); bf16_t* wB = (bf16_t*)(lb + GS_W); bf16_t* kB = (bf16_t*)(lb + GS_KD); bf16_t* qkB = (bf16_t*)(lb + GS_QK);
#pragma unroll
        for (int i = 0; i < 4; ++i) { const int e = lt + 256 * i, row = e >> 4, cc = e & 15; *(u32x4*)(qB + row * GK_STR + 8 * cc) = ls[i]; *(u32x4*)(wB + row * GK_STR + 8 * cc) = ls[4 + i];
            const int dk = 2 * row + (cc >> 3); *(u32x4*)(kB + dk * GT_STR + 8 * (cc & 7)) = ls[8 + i]; }
#pragma unroll
        for (int i = 0; i < 2; ++i) { const int e = lt + 256 * i, row = e >> 3, cc = e & 7; *(u32x4*)(qkB + row * GT_STR + 8 * cc) = ls[12 + i]; }
        if (lt < 64) ((float*)(lb + GS_EG))[lt] = eg;
    };
    auto uissue = [&](int c, u32x4 (&u0)[4]) {
        if (c >= nch) return;
        const int u = kind == 0 ? b * 516 + c * 4 + h : 2064 + b * 4 + h; const unsigned char* ex = p.ws + W_EX + (size_t)u * EXB;
#pragma unroll
        for (int j = 0; j < 4; ++j) u0[j] = *(const u32x4*)(ex + ((size_t)((wid * 2 + (j >> 1)) * 64 + lane)) * 32 + 16 * (j & 1));
    };
    auto lchunk = [&](int c, u32x4 (&lsn)[14], float& egn) {
        if (c + 1 < nch) { lstore((c + 1) & 1, lsn, egn); lissue(c + 3, lsn, egn); }
        __syncthreads();
    };
    auto chunk = [&](int c, u32x4 (&u0)[4]) {
        const int ntok = (kind == 0 && c == 0) ? 16 : 64;
        int lrv = lr, hiv = hi; asm volatile("" : "+v"(lrv), "+v"(hiv));
        const unsigned char* lb = lds + (c & 1) * GS_BUF;
        const bf16_t* qL = (const bf16_t*)(lb + GS_Q); const bf16_t* wL = (const bf16_t*)(lb + GS_W); const bf16_t* kdL = (const bf16_t*)(lb + GS_KD); const bf16_t* qkL = (const bf16_t*)(lb + GS_QK); const float* egL = (const float*)(lb + GS_EG);
        f32x16 uu[2];
#pragma unroll
        for (int tb = 0; tb < 2; ++tb)
#pragma unroll
            for (int q = 0; q < 8; ++q) { const unsigned w = ((const unsigned*)&u0[2 * tb + (q >> 2)])[q & 3]; uu[tb][2 * q] = bflo(w); uu[tb][2 * q + 1] = bfhi(w); }
        uissue(c + 2, u0);
        {
            f32x16 oo[2];
#pragma unroll
            for (int tb = 0; tb < 2; ++tb)
#pragma unroll
                for (int i = 0; i < 16; ++i) oo[tb][i] = 0.f;
            auto loadg = [&](int g, bf16x8 (&f)[4]) {
                if (g < 8) { f[0] = ld_perm(wL + lrv * GK_STR + 16 * g + 4 * hiv); f[1] = ld_perm(wL + (32 + lrv) * GK_STR + 16 * g + 4 * hiv); f[2] = ld_perm(qL + lrv * GK_STR + 16 * g + 4 * hiv); f[3] = ld_perm(qL + (32 + lrv) * GK_STR + 16 * g + 4 * hiv); }
                else if (g < 10) {
#pragma unroll
                    for (int ks = 0; ks < 4; ++ks) f[ks] = ld_perm(qkL + (32 * (g - 8) + lrv) * GT_STR + 16 * ks + 4 * hiv); }
                else {
#pragma unroll
                    for (int ks = 0; ks < 4; ++ks) f[ks] = ld_perm(kdL + (32 * (g - 10) + lrv) * GT_STR + 16 * ks + 4 * hiv); } };
            bf16x8 fa[4], fb[4], ub[4];
            const float egl = egL[63];
            loadg(0, fa);
            __builtin_amdgcn_sched_group_barrier(0x100, 4, 0);
#pragma unroll
            for (int g = 0; g < 14; ++g) {
                bf16x8 (&cur)[4] = (g & 1) ? fb : fa; bf16x8 (&nxt)[4] = (g & 1) ? fa : fb;
                if (g + 1 < 14) loadg(g + 1, nxt);
                if (g < 8) { const bf16x8 mbf = packs(Mst[g >> 1], g & 1);
                    uu[0] = MFMA32(cur[0], mbf, uu[0]); uu[1] = MFMA32(cur[1], mbf, uu[1]); oo[0] = MFMA32(cur[2], mbf, oo[0]); oo[1] = MFMA32(cur[3], mbf, oo[1]);
                    if (g == 7) {
#pragma unroll
                        for (int tb = 0; tb < 2; ++tb)
#pragma unroll
                            for (int i = 0; i < 16; ++i) oo[tb][i] *= egL[32 * tb + (i & 3) + 8 * (i >> 2) + 4 * hiv];
#pragma unroll
                        for (int ks = 0; ks < 4; ++ks) ub[ks] = packs(uu[ks >> 1], ks & 1); }
                } else if (g < 10) {
#pragma unroll
                    for (int ks = 0; ks < 4; ++ks) oo[g - 8] = MFMA32(cur[ks], ub[ks], oo[g - 8]);
                } else {
#pragma unroll
                    for (int i = 0; i < 16; ++i) Mst[g - 10][i] *= egl;
#pragma unroll
                    for (int ks = 0; ks < 4; ++ks) Mst[g - 10] = MFMA32(cur[ks], ub[ks], Mst[g - 10]);
                }
                if (g + 1 < 14) __builtin_amdgcn_sched_group_barrier(0x100, 4, 0);
                __builtin_amdgcn_sched_group_barrier(0x008, 4, 0);
            }
            { bf16_t* ob = O + (size_t)(gdn_row(kind, b, c, 0) + 4 * hiv) * D + h * 128 + dv;
              if (ntok == 64) {
#pragma unroll
                for (int tb = 0; tb < 2; ++tb)
#pragma unroll
                    for (int i = 0; i < 16; ++i) ob[(size_t)(32 * tb + (i & 3) + 8 * (i >> 2)) * D] = f2bf(oo[tb][i]);
              } else {
#pragma unroll
                for (int i = 0; i < 8; ++i) ob[(size_t)((i & 3) + 8 * (i >> 2)) * D] = f2bf(oo[0][i]);
              } }
        }
        __syncthreads();
    };
    if (wid >= 4) {
        lissue(0, lsE, egE); lstore(0, lsE, egE); lissue(1, lsO, egO); lissue(2, lsE, egE);
        __syncthreads();
        for (int c = 0; c < nch; c += 2) { lchunk(c, lsO, egO); if (c + 1 < nch) lchunk(c + 1, lsE, egE); }
    } else {
#pragma unroll
    for (int mb = 0; mb < 4; ++mb)
#pragma unroll
        for (int i = 0; i < 16; ++i) { const int dk = 32 * mb + (i & 3) + 8 * (i >> 2) + 4 * hi; Mst[mb][i] = (kind == 1) ? p.state_gdn[(((size_t)b * 4 + h) * 128 + dk) * 128 + dv] : 0.f; }
        uissue(0, u0E); uissue(1, u0O);
        __syncthreads();
        for (int c = 0; c < nch; c += 2) { chunk(c, u0E); if (c + 1 < nch) chunk(c + 1, u0O); }
        float* so = kind == 0 ? p.out + O_PGDN + ((size_t)b * 4 + h) * 16384 : p.out + O_SGDN + ((size_t)b * 4 + h) * 16384;
#pragma unroll
        for (int mb = 0; mb < 4; ++mb)
#pragma unroll
            for (int i = 0; i < 16; ++i) { const int dk = 32 * mb + (i & 3) + 8 * (i >> 2) + 4 * hi; so[dk * 128 + dv] = Mst[mb][i]; }
    }
    __syncthreads();
}

template <int DN, int QREG  , bool SAMPLE> DI void attn_unit(unsigned char* lds, const bf16_t* qa_row, const bf16_t* qr_row, const bf16_t* k1, int ldk1, const bf16_t* k2, int ldk2,
                                    const bf16_t* vt, int ldvt, int r0, int r1, int ntiles, int tmax_w, bf16_t* orow, bool store, int tid, int lane,
                                    const float* cckv = nullptr, const float* ckr = nullptr, int ps = 0) {
    constexpr int NKS = (DN + 64) / 16, KSTR = DN + 72, CPR = (DN + 64) / 8, NKC = 64 * CPR / 512, VSTR = 68;
    const int lr = lane & 31, hi = lane >> 5;
    constexpr int NQF = QREG == 1 ? NKS : (QREG == 2 ? DN / 16 : 4);
    bf16x8 qf[NQF];
#pragma unroll
    for (int ks = 0; ks < NKS; ++ks) { if (QREG == 1) qf[ks] = (16 * ks < DN) ? *(const bf16x8*)(qa_row + 16 * ks + 8 * hi) : *(const bf16x8*)(qr_row + (16 * ks - DN) + 8 * hi);
        else if (QREG == 2) { if (16 * ks < DN) qf[ks] = *(const bf16x8*)(qa_row + 16 * ks + 8 * hi); }
        else if (16 * ks >= DN) qf[ks - DN / 16] = *(const bf16x8*)(qr_row + (16 * ks - DN) + 8 * hi); }
    f32x16 oacc[4];
#pragma unroll
    for (int d = 0; d < 4; ++d)
#pragma unroll
        for (int i = 0; i < 16; ++i) oacc[d][i] = 0.f;
    float mrun = -INFINITY, lrun = 0.f;
    u32x4 kreg[SAMPLE ? 1 : NKC], vreg[2];
    constexpr int BUFB = 64 * KSTR * 2 + 128 * VSTR * 2;
    auto gload = [&](int t) { const int rb = t == 0 ? r0 : r1 + 64 * (t - 1);
#pragma unroll
        for (int i = 0; i < NKC; ++i) { const int e = tid + 512 * i, row = e / CPR, cc = e % CPR;
            kreg[i] = cc < DN / 8 ? *(const u32x4*)(k1 + (size_t)(rb + row) * ldk1 + 8 * cc) : *(const u32x4*)(k2 + (size_t)(rb + row) * ldk2 + 8 * (cc - DN / 8)); }
#pragma unroll
        for (int i = 0; i < 2; ++i) { const int e = tid + 512 * i, d = e >> 3, cc = e & 7; vreg[i] = *(const u32x4*)(vt + (size_t)d * ldvt + rb + 8 * cc); } };
    auto lstore = [&](int buf) { bf16_t* Kb = (bf16_t*)(lds + buf * BUFB); bf16_t* Vb = (bf16_t*)(lds + buf * BUFB + 64 * KSTR * 2);
#pragma unroll
        for (int i = 0; i < NKC; ++i) { const int e = tid + 512 * i, row = e / CPR, cc = e % CPR; *(u32x4*)(Kb + row * KSTR + 8 * cc) = kreg[i]; }
#pragma unroll
        for (int i = 0; i < 2; ++i) { const int e = tid + 512 * i, d = e >> 3, cc = e & 7; u32x2* q = (u32x2*)(Vb + d * VSTR + 8 * cc); q[0] = (u32x2){vreg[i].x, vreg[i].y}; q[1] = (u32x2){vreg[i].z, vreg[i].w}; } };
    auto compute = [&](const bf16_t* Kt, const bf16_t* Vt, int t) {
        f32x16 s0, s1;
#pragma unroll
        for (int i = 0; i < 16; ++i) { s0[i] = 0.f; s1[i] = 0.f; }
        if (QREG == 1 && !SAMPLE) {
            bf16x8 ka[3][2];
#pragma unroll
            for (int j = 0; j < 2; ++j) { ka[j][0] = *(const bf16x8*)(Kt + lr * KSTR + 16 * j + 8 * hi); ka[j][1] = *(const bf16x8*)(Kt + (32 + lr) * KSTR + 16 * j + 8 * hi); }
            __builtin_amdgcn_sched_group_barrier(0x100, 4, 0);
#pragma unroll
            for (int ks = 0; ks < NKS; ++ks) {
                if (ks + 2 < NKS) { ka[(ks + 2) % 3][0] = *(const bf16x8*)(Kt + lr * KSTR + 16 * (ks + 2) + 8 * hi); ka[(ks + 2) % 3][1] = *(const bf16x8*)(Kt + (32 + lr) * KSTR + 16 * (ks + 2) + 8 * hi); }
                s0 = MFMA32(ka[ks % 3][0], qf[ks < NQF ? ks : 0], s0); s1 = MFMA32(ka[ks % 3][1], qf[ks < NQF ? ks : 0], s1);
                if (ks + 2 < NKS) __builtin_amdgcn_sched_group_barrier(0x100, 2, 0);
                __builtin_amdgcn_sched_group_barrier(0x008, 2, 0);
            }
        } else {
#pragma unroll
        for (int ks = 0; ks < NKS; ++ks) { const bf16x8 a0 = *(const bf16x8*)(Kt + lr * KSTR + 16 * ks + 8 * hi), a1 = *(const bf16x8*)(Kt + (32 + lr) * KSTR + 16 * ks + 8 * hi);
            bf16x8 qq;
            if (QREG == 1) qq = qf[ks];
            else if (QREG == 2) qq = 16 * ks < DN ? qf[ks < NQF ? ks : 0] : *(const bf16x8*)(qr_row + (16 * ks - DN) + 8 * hi);
            else qq = 16 * ks < DN ? *(const bf16x8*)(qa_row + 16 * ks + 8 * hi) : qf[(16 * ks - DN) / 16 < NQF ? (16 * ks - DN) / 16 : 0];
            s0 = MFMA32(a0, qq, s0); s1 = MFMA32(a1, qq, s1);
            if ((ks & 3) == 3) __builtin_amdgcn_sched_barrier(0); }
        }
        if (t == 0) {
#pragma unroll
            for (int i = 0; i < 16; ++i) { if (i >= 8) s0[i] = -INFINITY; s1[i] = -INFINITY; } }
        float mx = s0[0];
#pragma unroll
        for (int i = 1; i < 16; ++i) mx = fmaxf(mx, s0[i]);
#pragma unroll
        for (int i = 0; i < 16; ++i) mx = fmaxf(mx, s1[i]);
        mx = xhalf_max(mx);
        const float mnew = fmaxf(mrun, mx), alpha = __builtin_amdgcn_exp2f(mrun - mnew);
        const bool resc = __builtin_amdgcn_ballot_w64(mnew != mrun) != 0ull; mrun = mnew;
        float ps = 0.f;
#pragma unroll
        for (int i = 0; i < 16; ++i) { s0[i] = __builtin_amdgcn_exp2f(s0[i] - mnew); s1[i] = __builtin_amdgcn_exp2f(s1[i] - mnew); ps += s0[i] + s1[i]; }
        lrun = lrun * alpha + ps;
        if (resc) {
#pragma unroll
            for (int d = 0; d < 4; ++d)
#pragma unroll
                for (int i = 0; i < 16; ++i) oacc[d][i] *= alpha; }
        bf16x8 pf[4]; pf[0] = packs(s0, 0); pf[1] = packs(s0, 1); pf[2] = packs(s1, 0); pf[3] = packs(s1, 1);
        if (QREG == 1 && !SAMPLE) {
            bf16x8 va[3];
#pragma unroll
            for (int j = 0; j < 2; ++j) va[j] = ld_perm(Vt + (32 * (j >> 2) + lr) * VSTR + 16 * (j & 3) + 4 * hi);
            __builtin_amdgcn_sched_group_barrier(0x100, 2, 0);
#pragma unroll
            for (int j = 0; j < 16; ++j) {
                if (j + 2 < 16) va[(j + 2) % 3] = ld_perm(Vt + (32 * ((j + 2) >> 2) + lr) * VSTR + 16 * ((j + 2) & 3) + 4 * hi);
                oacc[j >> 2] = MFMA32(va[j % 3], pf[j & 3], oacc[j >> 2]);
                if (j + 2 < 16) __builtin_amdgcn_sched_group_barrier(0x100, 1, 0);
                __builtin_amdgcn_sched_group_barrier(0x008, 1, 0);
            }
        } else {
#pragma unroll
        for (int d = 0; d < 4; ++d)
#pragma unroll
            for (int ks = 0; ks < 4; ++ks) { const bf16x8 a = ld_perm(Vt + (32 * d + lr) * VSTR + 16 * ks + 4 * hi); oacc[d] = MFMA32(a, pf[ks], oacc[d]); if (ks == 3) __builtin_amdgcn_sched_barrier(0); }
        }
    };
    if (SAMPLE) {
        bf16_t* Kt = (bf16_t*)lds; bf16_t* Vt = (bf16_t*)(lds + 64 * KSTR * 2);
        for (int t = 0; t < ntiles; ++t) {
            __syncthreads();
            const int rb = t == 0 ? r0 : r1 + 64 * (t - 1);
#pragma unroll
            for (int i = 0; i < NKC; ++i) { const int e = tid + 512 * i, row = e / CPR, cc = e % CPR; u32x4 w;
                if (t < 33) {
                    if (cc < 32) { const f32x4 a = *(const f32x4*)(cckv + (size_t)(rb + row) * 256 + 8 * cc), b2 = *(const f32x4*)(cckv + (size_t)(rb + row) * 256 + 8 * cc + 4); w.x = pk2(a.x, a.y); w.y = pk2(a.z, a.w); w.z = pk2(b2.x, b2.y); w.w = pk2(b2.z, b2.w); }
                    else { const int q8 = cc - 32; const f32x4 a = *(const f32x4*)(ckr + (size_t)(rb + row) * 64 + 4 * q8), b2 = *(const f32x4*)(ckr + (size_t)(rb + row) * 64 + 32 + 4 * q8); w.x = pk2(a.x, b2.x); w.y = pk2(a.y, b2.y); w.z = pk2(a.z, b2.z); w.w = pk2(a.w, b2.w); }
                } else w = cc < 32 ? *(const u32x4*)(k1 + (size_t)row * ldk1 + 8 * cc) : *(const u32x4*)(k2 + (size_t)row * ldk2 + 8 * (cc - 32));
                *(u32x4*)(Kt + row * KSTR + 8 * cc) = w;
                if (cc < 32 && (cc >> 4) == ps) { const int d0 = 8 * (cc - 16 * ps); const unsigned* wp = (const unsigned*)&w;
#pragma unroll
                    for (int j = 0; j < 4; ++j) { Vt[(d0 + 2 * j) * VSTR + row] = (bf16_t)(wp[j] & 0xffffu); Vt[(d0 + 2 * j + 1) * VSTR + row] = (bf16_t)(wp[j] >> 16); } }
            }
            __syncthreads();
            if (t <= tmax_w) compute(Kt, Vt, t);
        }
    } else {
        gload(0); lstore(0); if (ntiles > 1) gload(1);
        __syncthreads();
        for (int t = 0; t < ntiles; ++t) { const int cur = t & 1;
            if (t + 1 < ntiles) lstore(cur ^ 1);
            if (t + 2 < ntiles) gload(t + 2);
            if (t <= tmax_w) compute((const bf16_t*)(lds + cur * BUFB), (const bf16_t*)(lds + cur * BUFB + 64 * KSTR * 2), t);
            __syncthreads();
        }
    }
    const float lt = xhalf_sum(lrun), inv = 1.f / lt;
    if (store) {
#pragma unroll
        for (int d = 0; d < 4; ++d)
#pragma unroll
            for (int g = 0; g < 4; ++g) { u32x2 w; w.x = pk2(oacc[d][4 * g] * inv, oacc[d][4 * g + 1] * inv); w.y = pk2(oacc[d][4 * g + 2] * inv, oacc[d][4 * g + 3] * inv); *(u32x2*)(orow + 32 * d + 8 * g + 4 * hi) = w; }
    }
    __syncthreads();
}

#ifndef MIX_MASK
#define MIX_MASK 15
#endif
DI void phase_mix(const Prm& p, unsigned char* lds, int tid0, int wid, int lane0) {
    unsigned char* ws = p.ws; const bf16_t* Q = (const bf16_t*)(ws + W_Q); const bf16_t* KN = (const bf16_t*)(ws + W_KN); const bf16_t* VT = (const bf16_t*)(ws + W_VT);
    const bf16_t* HP = (const bf16_t*)(ws + W_HP);
    const bf16_t* QS = (const bf16_t*)(ws + W_QS); bf16_t* OL = (bf16_t*)(ws + W_OL); bf16_t* O = (bf16_t*)(ws + W_XN);
    unsigned* ctr = (unsigned*)(ws + W_CTR); unsigned* sh = (unsigned*)(lds + LDS_BYTES - 64);
    if ((MIX_MASK & 4) && blockIdx.x < 16) gdn_scan_unit(p, lds, 0, blockIdx.x >> 2, blockIdx.x & 3, tid0, wid, lane0);
    const int xcc = (int)(__builtin_amdgcn_s_getreg((3 << 11) | 20) & 7u);
    int qx = 0;
    for (;;) {
        __syncthreads();
        if (tid0 == 0) { int r = -1, q = qx;
            for (; q < 8; ++q) { const unsigned li = atomicAdd(ctr + 64 * ((xcc + q) & 7), 1u); if (li < 90u) { r = ((xcc + q) & 7) * 128 + (int)li; break; } }
            sh[0] = (unsigned)r; sh[1] = (unsigned)q; }
        __syncthreads();
        const int code = (int)sh[0]; qx = (int)sh[1];
        int lane = lane0, tid = tid0; asm volatile("" : "+v"(lane), "+v"(tid)); const int lr = lane & 31;
        if (code < 0) break;
        int it; { const int x = code >> 7, li = code & 127;
            if (li < 8) it = x * 8 + li;
            else if (li < 72) { const int j = li - 8; it = 64 + (j >> 1) * 16 + 2 * x + (j & 1); }
            else if (li < 88) it = 576 + x * 16 + (li - 72);
            else it = 704 + x * 2 + (li - 88); }
        if ((MIX_MASK & 1) && it < 64) {
            const int sb = it >> 1, ps = it & 1, hq = wid >> 1, qrow = sb * 64 + 32 * (wid & 1) + lr;
            attn_unit<256, 2, true>(lds, QS + (size_t)qrow * 1024 + hq * 256, Q + (size_t)(ROW_S + qrow) * 768 + hq * 192 + 128, HP + (size_t)(ROW_S + 64 * sb) * NPJ + C_CKV, NPJ, HP + (size_t)(ROW_S + 64 * sb) * NPJ + C_KR, NPJ,
                           nullptr, 0, 0, 16, 34, 33, OL + (size_t)qrow * 1024 + hq * 256 + 128 * ps, true, tid, lane, p.cache_ckv + (size_t)sb * 2064 * 256, p.cache_kr + (size_t)sb * 2064 * 64, ps);
        } else if ((MIX_MASK & 2) && it >= 64 && it < 576) {
            const int j = it - 64, qb = 31 - (j >> 4), bh = j & 15, b = bh >> 2, h = bh & 3; const int row = b * 8192 + 256 * qb + 32 * wid + lr;
            attn_unit<128, 1, false>(lds, Q + (size_t)row * 768 + h * 192, Q + (size_t)row * 768 + h * 192 + 128, KN + h * 128, 512, HP + C_KR, NPJ, VT + (size_t)(h * 128) * M, M,
                           ROW_META + 16 * b, b * 8192, 4 * qb + 5, 4 * qb + (wid >> 1) + 1, O + (size_t)row * D + 512 + h * 128, true, tid, lane);
        } else if ((MIX_MASK & 4) && it >= 576 && it < 704) {
            const int j = it - 576; gdn_scan_unit(p, lds, 1, j >> 2, j & 3, tid, wid, lane);
        } else if ((MIX_MASK & 8) && it >= 704) {
            const int j = it - 704, b = j >> 2, h = j & 3; const int row = ROW_META + 16 * b + lr;
            attn_unit<128, 1, false>(lds, Q + (size_t)row * 768 + h * 192, Q + (size_t)row * 768 + h * 192 + 128, KN + h * 128, 512, HP + C_KR, NPJ, VT + (size_t)(h * 128) * M, M,
                           ROW_META + 16 * b, b * 8192, 1, wid == 0 ? 0 : -1, O + (size_t)row * D + 512 + h * 128, wid == 0 && lane < 16 || (wid == 0 && lane >= 32 && lane < 48), tid, lane);
        }
    }
}

DI void phase_gdn_gate(const Prm& p, int gw, int ngw, int lane) {
    bf16_t* O = (bf16_t*)(p.ws + W_XN); const bf16_t* HP = (const bf16_t*)(p.ws + W_HP);
    for (int r = gw; r < ROW_PAD; r += ngw) {
        u32x4* q = (u32x4*)(O + (size_t)r * D) + lane; const u32x4 u = *q; const u32x4 z = *((const u32x4*)(HP + (size_t)r * NPJ + C_Z) + lane);
        float v[8] = {bflo(u.x), bfhi(u.x), bflo(u.y), bfhi(u.y), bflo(u.z), bfhi(u.z), bflo(u.w), bfhi(u.w)};
        float zz[8] = {bflo(z.x), bfhi(z.x), bflo(z.y), bfhi(z.y), bflo(z.z), bfhi(z.z), bflo(z.w), bfhi(z.w)};
        float ss = 0.f;
#pragma unroll
        for (int j = 0; j < 8; ++j) ss += v[j] * v[j];
        ss = row16_sum(ss);
        const float rstd = rsqrtf(ss * (1.f / 128.f) + 1e-6f); const int c0 = (8 * lane) & 127;
#pragma unroll
        for (int j = 0; j < 8; ++j) v[j] = v[j] * rstd * p.gdn_norm[c0 + j] * siluf(zz[j]);
        u32x4 w; w.x = pk2(v[0], v[1]); w.y = pk2(v[2], v[3]); w.z = pk2(v[4], v[5]); w.w = pk2(v[6], v[7]); *q = w;
    }
}

namespace pg8 {
#define PG8_LAS __attribute__((address_space(3)))
typedef unsigned short bf16_t;
typedef short bf16x8 __attribute__((ext_vector_type(8)));
typedef float f32x4 __attribute__((ext_vector_type(4)));
typedef unsigned u32x4 __attribute__((ext_vector_type(4)));
constexpr int BM = 256, BK = 64, HALF = 128, HTB = HALF * BK * 2  , STAGE_BYTES = 8 * HTB, NXCD = 8, WGM = 8;

__host__ __device__ __forceinline__ int lds_byte(int r, int c) { const int st = (r >> 4) * 2 + (c >> 5), rr = r & 15, cc = c & 31, ob = rr * 64 + cc * 2; return st * 1024 + (ob ^ (((ob >> 9) & 1) << 5)); }
__host__ __device__ __forceinline__ void stage_rc(int b, int& R, int& C) { const int st = b / 1024, sb = b % 1024, swz = sb ^ (((sb >> 9) & 1) << 5); R = (st >> 1) * 16 + swz / 64; C = (st & 1) * 32 + (swz % 64) / 2; }
__host__ __device__ __forceinline__ int perm32(int rho) { const int n = rho >> 4, i = rho & 15; return 8 * (i >> 2) + 4 * n + (i & 3); }

struct Unit { int pm, pn; size_t koff; int aux; };
struct Gemm { const bf16_t* A; const bf16_t* Bt; int M, N, K, lda, ldb; };

struct StaticOrder {
    int nM, nN, nwg, G, c;
    __host__ __device__ void init(int M, int N, int G_, int c_) { nM = M / BM; nN = N / BM; nwg = nM * nN; G = G_; c = c_; }
    __host__ __device__ bool mapL(long L, Unit& u) const {
        if (L >= nwg) return false;
        int wgid = (int)L; { const int q = nwg / NXCD, r = nwg % NXCD, xcd = wgid % NXCD, off = wgid / NXCD; wgid = (xcd < r ? xcd * (q + 1) : r * (q + 1) + (xcd - r) * q) + off; }
        const int nig = WGM * nN, gid = wgid / nig, fm = gid * WGM, gsz = (nM - fm) < WGM ? (nM - fm) : WGM;
        u.pm = fm + ((wgid % nig) % gsz); u.pn = (wgid % nig) / gsz; u.koff = 0; u.aux = 0; return true;
    }
    __host__ __device__ bool next(int i, Unit& u) const { return mapL((long)i * G + c, u); }
    __device__ __forceinline__ void a_ready(const Unit&) const {}
    __device__ __forceinline__ void done(const Unit&) const {}
};
struct HeadOrder { StaticOrder s; int cnt;
    __device__ bool next(int i, Unit& u) const { return i < cnt && s.next(i, u); }
    __device__ __forceinline__ void a_ready(const Unit&) const {}
    __device__ __forceinline__ void done(const Unit&) const {} };
struct TailOrder { StaticOrder s; int base, KS, total; size_t kbytes;
    __device__ bool next(int i, Unit& u) const { const int q = i * s.G + s.c; if (q >= total) return false; if (!s.mapL((long)base * s.G + q / KS, u)) return false; u.koff = (size_t)(q % KS) * kbytes; u.aux = q; return true; }
    __device__ __forceinline__ void a_ready(const Unit&) const {}
    __device__ __forceinline__ void done(const Unit&) const {} };

template <class Epi, class Sched, bool ALIGN_EPI = false, bool SP2 = false>
__device__ __forceinline__ void gemm_phase(PG8_LAS unsigned char* lds, const Gemm g, const Sched& S, const Epi& E) {
    int tid = threadIdx.x; asm volatile("" : "+v"(tid));
    const int wid = __builtin_amdgcn_readfirstlane(tid >> 6), lane = tid & 63, wr = wid >> 2, wc = wid & 3, fr = lane & 15, fq = lane >> 4;
    const int K = g.K, nt = K / BK;
    unsigned voffA[2], voffB[2];
#pragma unroll
    for (int i = 0; i < 2; ++i) { int R, C; stage_rc(tid * 16 + i * 8192, R, C); const int Rb = Epi::PERM ? ((R & ~31) + perm32(R & 31)) : R;
        voffA[i] = (unsigned)(R * g.lda + C) * 2u; voffB[i] = (unsigned)(Rb * g.ldb + C) * 2u; }
    const size_t kstep = (size_t)(BK * 2);
    const size_t hstepA = (size_t)HALF * g.lda * 2, hstepB = (size_t)HALF * g.ldb * 2;
    const size_t tstepA = 2 * hstepA, tstepB = 2 * hstepB;
    const unsigned ldsw = (unsigned)wid * 1024u;
    const int aoff = lds_byte(wr * 64 + fr, fq * 8), boff = lds_byte(wc * 32 + fr, fq * 8);
#define PG8_SA(b, h) (((b) * 2 + (h)) * HTB)
#define PG8_SB(b, h) ((4 + (b) * 2 + (h)) * HTB)
#define PG8_STAGE(bufoff, gbase, voff) do { _Pragma("unroll") for (int _i = 0; _i < 2; ++_i) \
        __builtin_amdgcn_global_load_lds((const unsigned*)((const char*)(gbase) + (voff)[_i]), (PG8_LAS unsigned*)(lds + (bufoff) + ldsw + _i * 8192), 16, 0, 0); } while (0)
#define PG8_LDA(dst, b, h) do { _Pragma("unroll") for (int m = 0; m < 4; ++m) _Pragma("unroll") for (int k = 0; k < 2; ++k) dst[m][k] = *(const PG8_LAS bf16x8*)(lds + PG8_SA(b, h) + aoff + m * 2048 + k * 1024); } while (0)
#define PG8_LDB(dst, b, h) do { _Pragma("unroll") for (int n = 0; n < 2; ++n) _Pragma("unroll") for (int k = 0; k < 2; ++k) dst[n][k] = *(const PG8_LAS bf16x8*)(lds + PG8_SB(b, h) + boff + n * 2048 + k * 1024); } while (0)
#define PG8_MMA(ai, bj, At, Bt) do { __builtin_amdgcn_s_setprio(1); _Pragma("unroll") for (int m = 0; m < 4; ++m) _Pragma("unroll") for (int n = 0; n < 2; ++n) _Pragma("unroll") for (int k = 0; k < 2; ++k) \
        acc[ai][bj][m][n] = __builtin_amdgcn_mfma_f32_16x16x32_bf16(Bt[n][k], At[m][k], acc[ai][bj][m][n], 0, 0, 0); __builtin_amdgcn_s_setprio(0); } while (0)
#define PG8_WAIT_V(n) asm volatile("s_waitcnt vmcnt(" #n ")" ::: "memory")
#define PG8_WAIT_L(n) asm volatile("s_waitcnt lgkmcnt(" #n ")" ::: "memory")
#define PG8_BAR __builtin_amdgcn_s_barrier()
#define PG8_SCHED __builtin_amdgcn_sched_barrier(0)
    Unit cur, nxt; int ui = 0;
    if (!S.next(0, cur)) return;
    f32x4 acc[2][2][4][2];
#pragma unroll
    for (int a = 0; a < 2; ++a)
#pragma unroll
        for (int b = 0; b < 2; ++b)
#pragma unroll
            for (int m = 0; m < 4; ++m)
#pragma unroll
                for (int n = 0; n < 2; ++n) acc[a][b][m][n] = (f32x4){0.f, 0.f, 0.f, 0.f};
    bf16x8 At[4][2], B0[2][2], B1[2][2];
    const char* cA = (const char*)g.A + (size_t)cur.pm * tstepA + cur.koff; const char* cB = (const char*)g.Bt + (size_t)cur.pn * tstepB + cur.koff;
    S.a_ready(cur);
    if constexpr (SP2) {
        PG8_STAGE(PG8_SB(0, 0), cB, voffB); PG8_STAGE(PG8_SB(0, 1), cB + hstepB, voffB); PG8_STAGE(PG8_SA(0, 0), cA, voffA); PG8_STAGE(PG8_SA(0, 1), cA + hstepA, voffA);
        if (wr == 1) PG8_BAR;
        PG8_WAIT_V(2); PG8_BAR;
        PG8_STAGE(PG8_SB(1, 0), cB + kstep, voffB); PG8_STAGE(PG8_SA(1, 0), cA + kstep, voffA); PG8_STAGE(PG8_SB(1, 1), cB + hstepB + kstep, voffB);
        PG8_WAIT_V(6); PG8_BAR;
    } else {
        PG8_STAGE(PG8_SB(0, 0), cB, voffB); PG8_STAGE(PG8_SA(0, 0), cA, voffA); PG8_STAGE(PG8_SB(0, 1), cB + hstepB, voffB); PG8_STAGE(PG8_SA(0, 1), cA + hstepA, voffA);
        if (wr == 1) PG8_BAR;
        PG8_WAIT_V(4); PG8_BAR;
        PG8_STAGE(PG8_SB(1, 0), cB + kstep, voffB); PG8_STAGE(PG8_SA(1, 0), cA + kstep, voffA); PG8_STAGE(PG8_SB(1, 1), cB + hstepB + kstep, voffB);
        PG8_WAIT_V(6); PG8_BAR;
    }
    for (;;) {
        const bool has_next = S.next(ui + 1, nxt);
        const char* nA = has_next ? (const char*)g.A + (size_t)nxt.pm * tstepA + nxt.koff : cA; const char* nB = has_next ? (const char*)g.Bt + (size_t)nxt.pn * tstepB + nxt.koff : cB;
        for (int t = 0; t < nt; t += 2) {
            const bool last = (t == nt - 2);
            const char* a1 = cA + (size_t)(t + 1) * kstep;
            const char* a2 = last ? nA : cA + (size_t)(t + 2) * kstep; const char* b2 = last ? nB : cB + (size_t)(t + 2) * kstep;
            const char* a3 = a2 + kstep; const char* b3 = b2 + kstep;
            if (last && has_next) S.a_ready(nxt);
            if constexpr (SP2) {
            PG8_LDB(B0, 0, 0); PG8_LDB(B1, 0, 1); PG8_SCHED; PG8_LDA(At, 0, 0); PG8_STAGE(PG8_SA(1, 1), a1 + hstepA, voffA);
            PG8_WAIT_V(8); PG8_WAIT_L(0); PG8_BAR; PG8_MMA(0, 0, At, B0); PG8_MMA(0, 1, At, B1); PG8_BAR; PG8_SCHED;
            PG8_LDA(At, 0, 1); PG8_STAGE(PG8_SB(0, 0), b2, voffB); PG8_STAGE(PG8_SB(0, 1), b2 + hstepB, voffB); PG8_STAGE(PG8_SA(0, 0), a2, voffA);
            PG8_WAIT_V(8); PG8_WAIT_L(0); PG8_BAR; PG8_MMA(1, 0, At, B0); PG8_MMA(1, 1, At, B1); PG8_BAR; PG8_SCHED;
            PG8_LDB(B0, 1, 0); PG8_LDB(B1, 1, 1); PG8_SCHED; PG8_LDA(At, 1, 0); PG8_STAGE(PG8_SA(0, 1), a2 + hstepA, voffA);
            PG8_WAIT_V(8); PG8_WAIT_L(0); PG8_BAR; PG8_MMA(0, 0, At, B0); PG8_MMA(0, 1, At, B1); PG8_BAR; PG8_SCHED;
            PG8_LDA(At, 1, 1); PG8_STAGE(PG8_SB(1, 0), b3, voffB); PG8_STAGE(PG8_SB(1, 1), b3 + hstepB, voffB); PG8_STAGE(PG8_SA(1, 0), a3, voffA);
            PG8_WAIT_V(8); PG8_WAIT_L(0); PG8_BAR; PG8_MMA(1, 0, At, B0); PG8_MMA(1, 1, At, B1); PG8_BAR; PG8_SCHED;
            } else {
            PG8_LDB(B0, 0, 0); PG8_SCHED; PG8_LDA(At, 0, 0); PG8_STAGE(PG8_SA(1, 1), a1 + hstepA, voffA);
            PG8_WAIT_L(8); PG8_BAR; PG8_WAIT_L(0); PG8_MMA(0, 0, At, B0); PG8_BAR; PG8_SCHED;
            PG8_LDB(B1, 0, 1); PG8_STAGE(PG8_SB(0, 0), b2, voffB);
            PG8_BAR; PG8_WAIT_L(0); PG8_MMA(0, 1, At, B1); PG8_BAR;
            PG8_LDA(At, 0, 1); PG8_STAGE(PG8_SA(0, 0), a2, voffA);
            PG8_BAR; PG8_WAIT_L(0); PG8_MMA(1, 0, At, B0); PG8_BAR; PG8_SCHED;
            PG8_STAGE(PG8_SB(0, 1), b2 + hstepB, voffB);
            PG8_WAIT_V(6); PG8_BAR; PG8_MMA(1, 1, At, B1); PG8_BAR;
            PG8_LDB(B0, 1, 0); PG8_SCHED; PG8_LDA(At, 1, 0); PG8_STAGE(PG8_SA(0, 1), a2 + hstepA, voffA);
            PG8_WAIT_L(8); PG8_BAR; PG8_WAIT_L(0); PG8_MMA(0, 0, At, B0); PG8_BAR; PG8_SCHED;
            PG8_LDB(B1, 1, 1); PG8_STAGE(PG8_SB(1, 0), b3, voffB);
            PG8_BAR; PG8_WAIT_L(0); PG8_MMA(0, 1, At, B1); PG8_BAR;
            PG8_LDA(At, 1, 1); PG8_STAGE(PG8_SA(1, 0), a3, voffA);
            PG8_BAR; PG8_WAIT_L(0); PG8_MMA(1, 0, At, B0); PG8_BAR; PG8_SCHED;
            PG8_STAGE(PG8_SB(1, 1), b3 + hstepB, voffB);
            PG8_WAIT_V(6); PG8_BAR; PG8_MMA(1, 1, At, B1); PG8_BAR;
            }
        }
        if constexpr (ALIGN_EPI) { if (wr == 0) PG8_BAR; }
        if constexpr (!Epi::AFTER_DRAIN) { E(acc, cur, wr, wc, fr, fq); S.done(cur); }
        if (!has_next) break;
#pragma unroll
        for (int a = 0; a < 2; ++a)
#pragma unroll
            for (int b = 0; b < 2; ++b)
#pragma unroll
                for (int m = 0; m < 4; ++m)
#pragma unroll
                    for (int n = 0; n < 2; ++n) acc[a][b][m][n] = (f32x4){0.f, 0.f, 0.f, 0.f};
        cur = nxt; cA = nA; cB = nB; ++ui;
        if constexpr (ALIGN_EPI) { if (wr == 1) PG8_BAR; }
    }
    PG8_WAIT_V(0);
    if constexpr (!ALIGN_EPI) { if (wr == 0) PG8_BAR; }
    PG8_BAR;
    if constexpr (Epi::AFTER_DRAIN) { E.fused(acc, cur, wr, wc, fr, fq, lds, wid, lane); S.done(cur); }
#undef PG8_SA
#undef PG8_SB
#undef PG8_STAGE
#undef PG8_LDA
#undef PG8_LDB
#undef PG8_MMA
#undef PG8_WAIT_V
#undef PG8_WAIT_L
#undef PG8_BAR
#undef PG8_SCHED
}
}

struct PEpiGU {
    static constexpr bool PERM = true, AFTER_DRAIN = false; bf16_t* H; const float* rss;
    DI void operator()(const f32x4 (&acc)[2][2][4][2], const pg8::Unit& u, int wr, int wc, int fr, int fq) const {
#pragma unroll
        for (int ai = 0; ai < 2; ++ai)
#pragma unroll
            for (int m = 0; m < 4; ++m) { const int r = u.pm * 256 + ai * 128 + wr * 64 + m * 16 + fr; bf16_t* rowp = H + (size_t)r * DFF + u.pn * 128 + wc * 32 + 8 * fq; float v[8]; const float sr = rss ? rss_rstd(rss, r) : 1.f;
#pragma unroll
                for (int n = 0; n < 2; ++n)
#pragma unroll
                    for (int e = 0; e < 4; ++e) v[4 * n + e] = siluf(acc[ai][0][m][n][e] * sr) * (acc[ai][1][m][n][e] * sr);
                u32x4 w; w.x = pk2(v[0], v[1]); w.y = pk2(v[2], v[3]); w.z = pk2(v[4], v[5]); w.w = pk2(v[6], v[7]); *(u32x4*)rowp = w; }
    }
};
struct PEpiRes {
    static constexpr bool PERM = false, AFTER_DRAIN = false; Prm p; float alpha; int from_inputs; bf16_t* xn; const float* gnext; float* rss;
    DI void operator()(const f32x4 (&acc)[2][2][4][2], const pg8::Unit& u, int wr, int wc, int fr, int fq) const {
        const int col0 = u.pn * 256 + wc * 32 + 4 * fq;
#pragma unroll
        for (int ai = 0; ai < 2; ++ai)
#pragma unroll
            for (int m = 0; m < 4; ++m) { const int r = u.pm * 256 + ai * 128 + wr * 64 + m * 16 + fr; float* rowp = xrow(p, r) + col0; const float* srcp = from_inputs ? x0row(p, r) : xrow(p, r); float ss = 0.f;
#pragma unroll
                for (int bj = 0; bj < 2; ++bj)
#pragma unroll
                    for (int n = 0; n < 2; ++n) { const int co = bj * 128 + n * 16; f32x4 x = srcp ? *(const f32x4*)(srcp + col0 + co) : (f32x4){0.f, 0.f, 0.f, 0.f}; x = x + acc[ai][bj][m][n] * alpha; *(f32x4*)(rowp + co) = x;
                        if (xn) { const f32x4 g = *(const f32x4*)(gnext + col0 + co); ss += x.x * x.x + x.y * x.y + x.z * x.z + x.w * x.w; u32x2 w; w.x = pk2(x.x * g.x, x.y * g.y); w.y = pk2(x.z * g.z, x.w * g.w); *(u32x2*)(xn + (size_t)r * D + col0 + co) = w; } }
                if (xn) { ss += __shfl_xor(ss, 16); ss += __shfl_xor(ss, 32); if (fq == 0) rss[(size_t)r * 16 + u.pn * 4 + wc] = ss; } }
    }
};
struct PEpiBf {
    static constexpr bool PERM = true, AFTER_DRAIN = false; bf16_t* O; int ldc; float sc; const float* rss;
    DI void operator()(const f32x4 (&acc)[2][2][4][2], const pg8::Unit& u, int wr, int wc, int fr, int fq) const {
#pragma unroll
        for (int ai = 0; ai < 2; ++ai)
#pragma unroll
            for (int m = 0; m < 4; ++m) { const int r = u.pm * 256 + ai * 128 + wr * 64 + m * 16 + fr; bf16_t* rowp = O + (size_t)r * ldc + u.pn * 256 + wc * 32 + 8 * fq; const float sr = rss ? sc * rss_rstd(rss, r) : sc;
#pragma unroll
                for (int bj = 0; bj < 2; ++bj) { const f32x4 a = acc[ai][bj][m][0] * sr, b = acc[ai][bj][m][1] * sr; u32x4 w; w.x = pk2(a[0], a[1]); w.y = pk2(a[2], a[3]); w.z = pk2(b[0], b[1]); w.w = pk2(b[2], b[3]); *(u32x4*)(rowp + bj * 128) = w; } }
    }
};
struct PEpiQ {
    static constexpr bool PERM = true, AFTER_DRAIN = false; bf16_t* Q; const float* tbl;
    DI void operator()(const f32x4 (&acc)[2][2][4][2], const pg8::Unit& u, int wr, int wc, int fr, int fq) const {
#pragma unroll
        for (int ai = 0; ai < 2; ++ai)
#pragma unroll
            for (int m = 0; m < 4; ++m) { const int r = u.pm * 256 + ai * 128 + wr * 64 + m * 16 + fr; const float* tb = tbl + (size_t)rowpos(r) * 64;
#pragma unroll
                for (int bj = 0; bj < 2; ++bj) { const int c = u.pn * 256 + bj * 128 + wc * 32 + 8 * fq, j = c % 192; const f32x4 a = acc[ai][bj][m][0], b = acc[ai][bj][m][1];
                    float v[8] = {a[0], a[1], a[2], a[3], b[0], b[1], b[2], b[3]};
                    if (j >= 128) { const int i0 = (j - 128) >> 1;
#pragma unroll
                        for (int q = 0; q < 4; ++q) { const float cs = tb[i0 + q], sn = tb[32 + i0 + q], x1 = v[2 * q], x2 = v[2 * q + 1]; v[2 * q] = x1 * cs - x2 * sn; v[2 * q + 1] = x2 * cs + x1 * sn; } }
                    u32x4 w; w.x = pk2(v[0] * QSCALE, v[1] * QSCALE); w.y = pk2(v[2] * QSCALE, v[3] * QSCALE); w.z = pk2(v[4] * QSCALE, v[5] * QSCALE); w.w = pk2(v[6] * QSCALE, v[7] * QSCALE);
                    *(u32x4*)(Q + (size_t)r * 768 + c) = w; } }
    }
};
struct PEpiPart {
    static constexpr bool PERM = false, AFTER_DRAIN = false; float* part;
    DI void operator()(const f32x4 (&acc)[2][2][4][2], const pg8::Unit& u, int wr, int wc, int fr, int fq) const {
        float* tp = part + (size_t)u.aux * 65536 + wc * 32 + 4 * fq;
#pragma unroll
        for (int ai = 0; ai < 2; ++ai)
#pragma unroll
            for (int m = 0; m < 4; ++m) { float* rowp = tp + (size_t)(ai * 128 + wr * 64 + m * 16 + fr) * 256;
#pragma unroll
                for (int bj = 0; bj < 2; ++bj)
#pragma unroll
                    for (int n = 0; n < 2; ++n) *(f32x4*)(rowp + bj * 128 + n * 16) = acc[ai][bj][m][n]; }
    }
};
constexpr int TAIL_KS = 2;
template <class Epi> DI void pgemm_head(unsigned char* lds, const bf16_t* A, int lda, const bf16_t* Bt, int ldb, int Mg, int Ng, int K, const Epi& E) {
    pg8::Gemm g{A, Bt, Mg, Ng, K, lda, ldb}; pg8::HeadOrder S; S.s.init(Mg, Ng, (int)gridDim.x, (int)blockIdx.x); S.cnt = S.s.nwg / (int)gridDim.x;
    pg8::gemm_phase<Epi, pg8::HeadOrder, true, true>((PG8_LAS unsigned char*)lds, g, S, E);
    __syncthreads();
}
DI void pgemm_tail(unsigned char* lds, const bf16_t* A, int lda, const bf16_t* Bt, int ldb, int Mg, int Ng, int K, float* part) {
    pg8::TailOrder S; S.s.init(Mg, Ng, (int)gridDim.x, (int)blockIdx.x); S.base = S.s.nwg / (int)gridDim.x; S.KS = TAIL_KS; S.total = (S.s.nwg % (int)gridDim.x) * TAIL_KS; S.kbytes = (size_t)(K / TAIL_KS) * 2;
    pg8::Gemm g{A, Bt, Mg, Ng, K / TAIL_KS, lda, ldb};
    pg8::gemm_phase<PEpiPart, pg8::TailOrder, true, true>((PG8_LAS unsigned char*)lds, g, S, PEpiPart{part});
    __syncthreads();
}
DI void tail_combine(const Prm& p, int Mg, int Ng, const float* part, float alpha, int from_inputs, bf16_t* xn, const float* gnext, float* rss, int gw, int ngw, int lane) {
    pg8::StaticOrder S; S.init(Mg, Ng, (int)gridDim.x, 0); const int base = S.nwg / (int)gridDim.x, ntail = S.nwg % (int)gridDim.x;
    for (int it = gw; it < ntail * 256; it += ngw) { const int j = it >> 8, rr = it & 255; pg8::Unit u; S.mapL((long)base * S.G + j, u);
        const int r = u.pm * 256 + rr, col = u.pn * 256 + 4 * lane; const float* srcp = from_inputs ? x0row(p, r) : xrow(p, r);
        f32x4 x = srcp ? *(const f32x4*)(srcp + col) : (f32x4){0.f, 0.f, 0.f, 0.f};
#pragma unroll
        for (int kz = 0; kz < TAIL_KS; ++kz) x = x + *(const f32x4*)(part + (size_t)(j * TAIL_KS + kz) * 65536 + rr * 256 + 4 * lane) * alpha;
        *(f32x4*)(xrow(p, r) + col) = x;
        if (xn) { const f32x4 g = *(const f32x4*)(gnext + col); u32x2 w; w.x = pk2(x.x * g.x, x.y * g.y); w.y = pk2(x.z * g.z, x.w * g.w); *(u32x2*)(xn + (size_t)r * D + col) = w;
            const float ss = wave_sum(x.x * x.x + x.y * x.y + x.z * x.z + x.w * x.w); if (lane < 4) rss[(size_t)r * 16 + u.pn * 4 + lane] = lane == 0 ? ss : 0.f; } }
}
DI void late_panels(int Mg, int Ng, unsigned (&mask)[5], unsigned char* lds, int tid) {
    unsigned* lm = (unsigned*)(lds + 1024);
    pg8::StaticOrder S; S.init(Mg, Ng, (int)gridDim.x, 0); const int base = S.nwg / (int)gridDim.x, ntail = S.nwg % (int)gridDim.x;
    __syncthreads();
    if (tid < 5) lm[tid] = 0u;
    __syncthreads();
    for (int j = tid; j < ntail; j += 512) { pg8::Unit u; S.mapL((long)base * S.G + j, u); atomicOr(lm + (u.pm >> 5), 1u << (u.pm & 31)); }
    __syncthreads();
#pragma unroll
    for (int i = 0; i < 5; ++i) mask[i] = lm[i];
    __syncthreads();
}
template <class Epi> DI void pgemm(unsigned char* lds, const bf16_t* A, int lda, const bf16_t* Bt, int ldb, int Mg, int Ng, int K, const Epi& E) {
    pg8::Gemm g{A, Bt, Mg, Ng, K, lda, ldb}; pg8::StaticOrder S; S.init(Mg, Ng, (int)gridDim.x, (int)blockIdx.x);
    pg8::gemm_phase<Epi, pg8::StaticOrder, true, true>((PG8_LAS unsigned char*)lds, g, S, E);
    __syncthreads();
}

#define LAS __attribute__((address_space(3)))
#define XB_TMO      128
#define XB_XCNT(j)  (256  + 64 * (j))
#define XB_XSUB(j)  (1280 + 64 * (j))
#define XB_XGEN(j)  (2304 + 64 * (j))
#define XB_TOP      3328
#define XB_TOPGEN   3392
#define XCD_BAR_WORDS 3456
#define XB_SPIN_CAP (1u << 22)

__device__ __forceinline__ unsigned xb_ld(unsigned* p)              { return __hip_atomic_load(p, __ATOMIC_RELAXED, __HIP_MEMORY_SCOPE_AGENT); }
__device__ __forceinline__ unsigned xb_add(unsigned* p, unsigned v) { return __hip_atomic_fetch_add(p, v, __ATOMIC_RELAXED, __HIP_MEMORY_SCOPE_AGENT); }
__device__ __forceinline__ unsigned xb_xcc_id() { return (unsigned)__builtin_amdgcn_s_getreg((3 << 11) | 20) & 0xFu; }
#define XB_SPIN(cond, bar) do { unsigned _sp = 0; while (cond) { __builtin_amdgcn_s_sleep(1); \
    if ((++_sp & 255u) == 0u) { if (xb_ld(&(bar)[XB_TMO])) break; if (_sp > XB_SPIN_CAP) { atomicAdd(&(bar)[XB_TMO], 1u); break; } } } } while (0)

struct XcdBarrier {
    unsigned* bar; unsigned x;
    volatile LAS unsigned* st;
};

__device__ __forceinline__ XcdBarrier xcd_barrier_post(unsigned* bar, volatile LAS unsigned* st) {
    XcdBarrier b; b.bar = bar; b.x = xb_xcc_id(); b.st = st;
    if (threadIdx.x == 0) (void)xb_add(&bar[XB_XCNT(b.x)], 1u);
    return b;
}
__device__ __forceinline__ void xcd_barrier_complete(unsigned* bar, unsigned x, unsigned& nloc, unsigned& nx) {
    const unsigned G = gridDim.x * gridDim.y * gridDim.z;
    unsigned sum, cnt, mine, sp = 0u;
    for (;;) {
        sum = 0u; cnt = 0u; mine = 0u;
#pragma unroll
        for (unsigned j = 0; j < 16; ++j) { const unsigned c = xb_ld(&bar[XB_XCNT(j)]); sum += c; cnt += (c > 0u) ? 1u : 0u; mine = (j == x) ? c : mine; }
        if (sum == G) break;
        __builtin_amdgcn_s_sleep(1);
        if ((++sp & 255u) == 0u) { if (xb_ld(&bar[XB_TMO])) break; if (sp > XB_SPIN_CAP) { atomicAdd(&bar[XB_TMO], 1u); break; } }
    }
    nloc = mine > 0u ? mine : 1u; nx = cnt > 0u ? cnt : 1u;
}

__device__ __forceinline__ void xcd_barrier(const XcdBarrier& b) {
    asm volatile("s_waitcnt vmcnt(0)" ::: "memory");
    __syncthreads();
    if (threadIdx.x == 0) {
        unsigned* bar = b.bar;
        __builtin_amdgcn_s_waitcnt(0);
        unsigned nloc = b.st[0], nx = b.st[1];
        if (nloc == 0u) { xcd_barrier_complete(bar, b.x, nloc, nx); b.st[0] = nloc; b.st[1] = nx; }
        const unsigned old = xb_add(&bar[XB_XSUB(b.x)], 1u);
        const unsigned gen = old / nloc;
        if (old + 1u == (gen + 1u) * nloc) {
            __builtin_amdgcn_fence(__ATOMIC_RELEASE, "agent");
            asm volatile("s_waitcnt vmcnt(0)" ::: "memory");
            const unsigned og = xb_add(&bar[XB_TOP], 1u);
            const unsigned tg = og / nx;
            if (og + 1u == (tg + 1u) * nx) xb_add(&bar[XB_TOPGEN], 1u);
            else XB_SPIN(xb_ld(&bar[XB_TOPGEN]) == tg, bar);
            __builtin_amdgcn_fence(__ATOMIC_ACQUIRE, "agent");
            xb_add(&bar[XB_XGEN(b.x)], 1u);
            asm volatile("s_waitcnt vmcnt(0)" ::: "memory");
        } else {
            XB_SPIN(xb_ld(&bar[XB_XGEN(b.x)]) == gen, bar);
            __builtin_amdgcn_fence(__ATOMIC_ACQUIRE, "agent");
            asm volatile("s_waitcnt vmcnt(0)" ::: "memory");
        }
    }
    __syncthreads();
}

constexpr int NPHASE = 17;
DI void run_phase(const Prm& p, int ph, unsigned char* lds, int tid, int wid, int lane) {
    unsigned char* ws = p.ws; const int gw = blockIdx.x * 8 + wid, ngw = gridDim.x * 8;
    bf16_t* XN = (bf16_t*)(ws + W_XN); bf16_t* HP = (bf16_t*)(ws + W_HP);
    switch (ph) {
    case 0: phase_prep(p, tid, lane, wid); break;
    case 1: pgemm(lds, XN, D, (const bf16_t*)(ws + W_WGU1), D, M, 5632, D, PEpiGU{HP, nullptr});
        {
            const int G = (int)gridDim.x, rem = ((M / 256) * (5632 / 256)) % G, c = (int)blockIdx.x;
            if (rem == 0) cvt_ffn(p, 0, c * 512 + tid, G * 512, 2); else if (c >= rem) cvt_ffn(p, 0, (c - rem) * 512 + tid, (G - rem) * 512, 2);
        }
        break;
    case 2: pgemm_head(lds, HP, DFF, (const bf16_t*)(ws + W_WD1), DFF, M, D, DFF, PEpiRes{p, 0.5f, 1, XN, p.mix_norm, (float*)(ws + W_RSS)}); break;
    case 19: pgemm_tail(lds, HP, DFF, (const bf16_t*)(ws + W_WD1), DFF, M, D, DFF, (float*)(ws + W_Q));
        {
            const int G = (int)gridDim.x, nt_ = (((M / 256) * (D / 256)) % G) * TAIL_KS, c = (int)blockIdx.x;
            if (nt_ == 0 || nt_ >= G) prep_late(p, c * 512 + tid, G * 512); else if (c >= nt_) prep_late(p, (c - nt_) * 512 + tid, (G - nt_) * 512);
        }
        break;
    case 20: tail_combine(p, M, D, (const float*)(ws + W_Q), 0.5f, 1, XN, p.mix_norm, (float*)(ws + W_RSS), gw, ngw, lane); break;
    case 4: pgemm(lds, XN, D, (const bf16_t*)(ws + W_WIN), D, M, NPJ, D, PEpiBf{HP, NPJ, 1.f, (const float*)(ws + W_RSS)}); break;
    case 5: phase_post(p, gw, ngw, lane); break;
    case 6: pgemm(lds, HP + C_CQ, NPJ, (const bf16_t*)(ws + W_WUQ), 384, M, 768, 384, PEpiBf{(bf16_t*)(ws + W_Q), 768, QSCALE, nullptr}); break;
    case 15: pgemm(lds, HP + C_CKV, NPJ, (const bf16_t*)(ws + W_WKN), 256, M, 512, 256, PEpiBf{(bf16_t*)(ws + W_KN), 512, 1.f, nullptr}); break;
    case 16: pgemm(lds, (const bf16_t*)(ws + W_WVT), 256, HP + C_CKV, NPJ, 512, M, 256, PEpiBf{(bf16_t*)(ws + W_VT), M, 1.f, nullptr}); break;
    case 17: phase_gdn_pre(p, lds, tid, wid, lane); break;
    case 7:
        {
            bf16_t* Qb = (bf16_t*)(ws + W_Q); const float* tbl = (const float*)(ws + W_TBL);
            for (int it = blockIdx.x * 512 + tid; it < M * 32; it += gridDim.x * 512) { const int r = it >> 5, h = (it >> 3) & 3, q8 = it & 7; u32x4* qp = (u32x4*)(Qb + (size_t)r * 768 + h * 192 + 128 + 8 * q8); u32x4 u = *qp; const float* tb = tbl + (size_t)rowpos(r) * 64 + 4 * q8;
                unsigned* uu = (unsigned*)&u;
#pragma unroll
                for (int q = 0; q < 4; ++q) { const float x1 = bflo(uu[q]), x2 = bfhi(uu[q]), cs = tb[q], sn = tb[32 + q]; uu[q] = pk2(x1 * cs - x2 * sn, x2 * cs + x1 * sn); }
                *qp = u; }
        }
        for (int h = 0; h < 4; ++h)
            gemm_simple((const bf16_t*)(ws + W_Q) + (size_t)ROW_S * 768 + h * 192, 768, (const bf16_t*)(ws + W_WUKV) + h * 256, 1024, 2048, 256, 128, EpiBf{(bf16_t*)(ws + W_QS) + h * 256, 1024}, gw, ngw, lane);
        break;
    case 8: phase_mix(p, lds, tid, wid, lane); break;
    case 9:
        phase_gdn_gate(p, gw, ngw, lane);
        for (int h = 0; h < 4; ++h)
            gemm_simple((const bf16_t*)(ws + W_OL) + h * 256, 1024, (const bf16_t*)(ws + W_WVT) + (size_t)h * 128 * 256, 256, 2048, 128, 256, EpiBf{XN + (size_t)ROW_S * D + 512 + h * 128, D}, gw, ngw, lane);
        break;
    case 10: pgemm(lds, XN, D, (const bf16_t*)(ws + W_WO), D, M, D, D, PEpiRes{p, 1.0f, 0, (bf16_t*)(ws + W_Q), p.ffn2_norm, (float*)(ws + W_RSS) + (size_t)M * 16}); break;
    case 12: pgemm(lds, (const bf16_t*)(ws + W_Q), D, (const bf16_t*)(ws + W_WGU2), D, M, 5632, D, PEpiGU{HP, (const float*)(ws + W_RSS) + (size_t)M * 16}); break;
    case 13: pgemm_head(lds, HP, DFF, (const bf16_t*)(ws + W_WD2), DFF, M, D, DFF, PEpiRes{p, 0.5f, 0, nullptr, nullptr, nullptr}); break;
    case 21: pgemm_tail(lds, HP, DFF, (const bf16_t*)(ws + W_WD2), DFF, M, D, DFF, (float*)(ws + W_VT));
        {
            const int G = (int)gridDim.x, nt_ = (((M / 256) * (D / 256)) % G) * TAIL_KS, c = (int)blockIdx.x;
            if (nt_ > 0 && nt_ < G && c >= nt_) { unsigned mask[5]; late_panels(M, D, mask, lds, tid);
                for (int pnl = c - nt_; pnl < ROW_META / 256; pnl += G - nt_) final_norm_rows(p, pnl * 256, pnl * 256 + 256, wid, 8, lane, mask, 0u); }
        }
        break;
    case 22: tail_combine(p, M, D, (const float*)(ws + W_VT), 0.5f, 0, nullptr, nullptr, nullptr, gw, ngw, lane); break;
    case 14: { unsigned mask[5]; late_panels(M, D, mask, lds, tid); const int G = (int)gridDim.x, nt_ = (((M / 256) * (D / 256)) % G) * TAIL_KS;
        if (nt_ > 0 && nt_ < G) final_norm_rows(p, 0, ROW_META, gw, ngw, lane, mask, 1u);
        else { unsigned all0[5] = {0u, 0u, 0u, 0u, 0u}; final_norm_rows(p, 0, ROW_META, gw, ngw, lane, all0, 0u); } }
        break;
    default: break;
    }
}

#if MEGA
__global__ void __launch_bounds__(512) k_fwd(Prm p) {
    extern __shared__ __attribute__((aligned(16))) unsigned char lds[];
    const int tid = threadIdx.x, lane = tid & 63, wid = __builtin_amdgcn_readfirstlane(tid >> 6);
    cg::grid_group grid = cg::this_grid();
    volatile LAS unsigned* bst = (volatile LAS unsigned*)((LAS unsigned char*)lds + (LDS_BYTES - 32));
    if (tid == 0) { bst[0] = 0u; bst[1] = 0u; }
    __syncthreads();
    const XcdBarrier xbar = xcd_barrier_post((unsigned*)(p.ws + W_BAR), bst);
#define GSYNC() xcd_barrier(xbar)
#ifndef DUP
#define DUP -1
#endif
#define RUN_PH1(n) { int t_ = tid; asm volatile("" : "+v"(t_)); run_phase(p, n, lds, t_, __builtin_amdgcn_readfirstlane(t_ >> 6), t_ & 63); }
#define RUN_PH(n) RUN_PH1(n) if (DUP == n) { grid.sync(); if (n == 8) { if (blockIdx.x == 0 && tid == 0) ((unsigned*)(p.ws + W_CTR))[0] = 0u; grid.sync(); } RUN_PH1(n) }
    if (p.pad == 0x5eed) grid.sync();
    RUN_PH(0) GSYNC(); RUN_PH(1) GSYNC(); RUN_PH(2) GSYNC(); RUN_PH(19) GSYNC(); RUN_PH(20) GSYNC(); RUN_PH(4) GSYNC(); RUN_PH(5) GSYNC(); RUN_PH(6) RUN_PH(15) RUN_PH(16) RUN_PH(17) GSYNC(); RUN_PH(7) GSYNC();
    RUN_PH(8) GSYNC(); RUN_PH(9) GSYNC(); RUN_PH(10) GSYNC(); RUN_PH(12) GSYNC(); RUN_PH(13) GSYNC(); RUN_PH(21) GSYNC(); RUN_PH(22) GSYNC(); RUN_PH(14)
}
#else
template <int PH> __global__ void __launch_bounds__(512) k_ph(Prm p) {
    extern __shared__ __attribute__((aligned(16))) unsigned char lds[];
    const int tid = threadIdx.x, lane = tid & 63, wid = __builtin_amdgcn_readfirstlane(tid >> 6);
    run_phase(p, PH, lds, tid, wid, lane);
}
template <int PH> static void launch_ph(const Prm& p, int grid, hipStream_t stream) {
    (void)hipFuncSetAttribute((const void*)k_ph<PH>, hipFuncAttributeMaxDynamicSharedMemorySize, LDS_BYTES);
    hipLaunchKernelGGL(k_ph<PH>, dim3(grid), dim3(512), LDS_BYTES, stream, p);
}
#endif

extern "C" void kernel_launch(void* const* d_in, const int* in_sizes, int n_in, void* d_out, int out_size, void* d_ws, size_t ws_size, hipStream_t stream) {
    static int grid = 0;
    if (grid == 0) {
        int dev = 0, cus = 0; (void)hipGetDevice(&dev); (void)hipDeviceGetAttribute(&cus, hipDeviceAttributeMultiprocessorCount, dev);
#if MEGA
        (void)hipFuncSetAttribute((const void*)k_fwd, hipFuncAttributeMaxDynamicSharedMemorySize, LDS_BYTES);
        int per_cu = 0; (void)hipOccupancyMaxActiveBlocksPerMultiprocessor(&per_cu, (const void*)k_fwd, 512, LDS_BYTES);
        if (per_cu < 1) fprintf(stderr, "occupancy query says %d\n", per_cu);
#endif
        grid = cus > 0 ? cus : 256;
        if (n_in != 27 || ws_size < W_END) { fprintf(stderr, "kernel_launch: unexpected n_in %d or ws_size %zu (< %zu)\n", n_in, ws_size, (size_t)W_END); }
    }
    Prm p{};
    const float** f = (const float**)&p;
    for (int i = 0; i < 27; ++i) f[i] = (const float*)d_in[i];
    p.out = (float*)d_out; p.ws = (unsigned char*)d_ws; p.phase = 0; p.pad = 0;
#if MEGA
    (void)hipMemsetAsync((char*)d_ws + W_BAR, 0, 16384, stream);
    void* args[] = {&p};
    hipError_t e = hipLaunchCooperativeKernel((const void*)k_fwd, dim3(grid), dim3(512), args, LDS_BYTES, stream);
    if (e != hipSuccess) fprintf(stderr, "cooperative launch failed: %s\n", hipGetErrorString(e));
#else
    launch_ph<0>(p, grid, stream); launch_ph<1>(p, grid, stream); launch_ph<2>(p, grid, stream); launch_ph<19>(p, grid, stream); launch_ph<20>(p, grid, stream); launch_ph<4>(p, grid, stream);
    launch_ph<5>(p, grid, stream); launch_ph<6>(p, grid, stream); launch_ph<15>(p, grid, stream); launch_ph<16>(p, grid, stream); launch_ph<17>(p, grid, stream); launch_ph<7>(p, grid, stream); launch_ph<8>(p, grid, stream); launch_ph<9>(p, grid, stream);
    launch_ph<10>(p, grid, stream); launch_ph<12>(p, grid, stream); launch_ph<13>(p, grid, stream); launch_ph<21>(p, grid, stream); launch_ph<22>(p, grid, stream); launch_ph<14>(p, grid, stream);
#endif
}
```
